# Optimizing an MI355X kernel written in HIP

```python
import math
import jax, jax.numpy as jnp
from jax import lax
import numpy as np

D_MODEL = 1024
BATCH = 32
SEQ = 2048
DEPTH = 1

N_HEADS = 8
HEAD_DIM = 64
ATT_WIDTH = N_HEADS * HEAD_DIM
PATTERNS = ((128, 1), (512, 4), (2048, 16))
SSM_GROUPS = 16
SSM_GROUP_CH = 16
SSM_WIDTH = SSM_GROUPS * SSM_GROUP_CH
SSM_STATE = 64
D_FF = 2048
CONV_W = 3
IN_WIDTH = 3 * ATT_WIDTH + SSM_WIDTH + 2 * D_MODEL
EPS = 1e-6
NEG_INF = -1e30

kernel_name = "gated_dilated_attn_s5_hybrid_block"


def _rmsnorm(x, g):
    x32 = x.astype(jnp.float32)
    y = x32 * lax.rsqrt(jnp.mean(x32 * x32, axis=-1, keepdims=True) + EPS)
    return y.astype(x.dtype) * g


def _modulate(x, g, shift, scale):
    return _rmsnorm(x, g) * (1 + scale[:, None, :]) + shift[:, None, :]


def _alibi_slopes():
    return np.array([2.0 ** (-8.0 * (h + 1) / N_HEADS) for h in range(N_HEADS)], dtype=np.float32)


def _dilated_window_attention(q, k, v, slopes, window, dilation):
    b, s, h, hd = q.shape
    w = window // dilation
    L = s // dilation
    nb = -(-L // w)
    Lp = nb * w
    X = b * dilation

    def to_sub(t):
        t = t.reshape(b, L, dilation, h, hd).transpose(0, 2, 3, 1, 4)
        return t.reshape(X, h, L, hd)

    qs, ks, vs = to_sub(q), to_sub(k), to_sub(v)
    qb = jnp.pad(qs, ((0, 0), (0, 0), (0, Lp - L), (0, 0))).reshape(X, h, nb, w, hd)
    kp = jnp.pad(ks, ((0, 0), (0, 0), (w, Lp - L), (0, 0)))
    vp = jnp.pad(vs, ((0, 0), (0, 0), (w, Lp - L), (0, 0)))
    kb = jnp.concatenate([kp[:, :, :Lp].reshape(X, h, nb, w, hd),
                          kp[:, :, w:].reshape(X, h, nb, w, hd)], axis=3)
    vb = jnp.concatenate([vp[:, :, :Lp].reshape(X, h, nb, w, hd),
                          vp[:, :, w:].reshape(X, h, nb, w, hd)], axis=3)

    a_idx = np.arange(w)[:, None]
    j_idx = np.arange(2 * w)[None, :]
    dist = (w + a_idx - j_idx).astype(np.float32)
    kpos = np.arange(nb)[:, None, None] * w - w + j_idx[None]
    valid = (dist[None] >= 0) & (dist[None] <= w) & (kpos >= 0)
    bias = -(slopes[:, None, None] * dilation) * dist[None]

    scale = HEAD_DIM ** -0.5
    sc = jnp.einsum('xhnqd,xhnkd->xhnqk', qb, kb).astype(jnp.float32) * scale
    sc = jnp.where(valid, sc + bias[:, None], NEG_INF)
    m = jnp.max(sc, axis=-1, keepdims=True)
    p = jnp.exp(sc - m)
    den = jnp.sum(p, axis=-1, keepdims=True)
    o = jnp.einsum('xhnqk,xhnkd->xhnqd', p, vb.astype(jnp.float32)) / den
    lse = (m + jnp.log(den))[..., 0]

    o = o.reshape(X, h, Lp, hd)[:, :, :L].reshape(b, dilation, h, L, hd)
    o = o.transpose(0, 3, 1, 2, 4).reshape(b, s, h, hd)
    lse = lse.reshape(X, h, Lp)[:, :, :L].reshape(b, dilation, h, L)
    lse = lse.transpose(0, 3, 1, 2).reshape(b, s, h)
    return o, lse


def _s5_branch(u, a_re, a_im, log_dt, b_re, b_im, c_re, c_im, d_skip, w_glu, b_glu):
    f32 = jnp.float32
    bsz, s, _ = u.shape
    lr, li = a_re.astype(f32), a_im.astype(f32)
    dt = jnp.exp(log_dt.astype(f32))[:, None]
    mag = jnp.exp(lr * dt)
    ang = li * dt
    ab_re, ab_im = mag * jnp.cos(ang), mag * jnp.sin(ang)
    nr, ni = ab_re - 1.0, ab_im
    den = lr * lr + li * li
    f_re = (nr * lr + ni * li) / den
    f_im = (ni * lr - nr * li) / den
    br, bi = b_re.astype(f32), b_im.astype(f32)
    bb_re = f_re[..., None] * br - f_im[..., None] * bi
    bb_im = f_re[..., None] * bi + f_im[..., None] * br

    ug = u.astype(f32).reshape(bsz, s, SSM_GROUPS, SSM_GROUP_CH)
    bu_re = jnp.einsum('bsgc,gnc->bsgn', ug, bb_re)
    bu_im = jnp.einsum('bsgc,gnc->bsgn', ug, bb_im)
    a_re_t = jnp.broadcast_to(ab_re, bu_re.shape)
    a_im_t = jnp.broadcast_to(ab_im, bu_re.shape)

    def combine(left, right):
        ar1, ai1, xr1, xi1 = left
        ar2, ai2, xr2, xi2 = right
        return (ar2 * ar1 - ai2 * ai1,
                ar2 * ai1 + ai2 * ar1,
                ar2 * xr1 - ai2 * xi1 + xr2,
                ar2 * xi1 + ai2 * xr1 + xi2)

    _, _, xr, xi = lax.associative_scan(combine, (a_re_t, a_im_t, bu_re, bu_im), axis=1)
    y = (jnp.einsum('bsgn,gcn->bsgc', xr, c_re.astype(f32))
         - jnp.einsum('bsgn,gcn->bsgc', xi, c_im.astype(f32))
         + d_skip.astype(f32).reshape(SSM_GROUPS, SSM_GROUP_CH) * ug)
    y = y.reshape(bsz, s, SSM_WIDTH).astype(u.dtype)
    y = jax.nn.gelu(y)
    return y * jax.nn.sigmoid(y @ w_glu + b_glu)


def _hybrid_mixer(u, w_in, b_gate, a_re, a_im, log_dt, b_re, b_im, c_re, c_im,
                  d_skip, w_glu, b_glu, w_proj_att, w_proj_ssm, w_out):
    bsz, s, _ = u.shape
    proj = u @ w_in
    q, k, v, us, g_att, g_ssm = jnp.split(
        proj, [ATT_WIDTH, 2 * ATT_WIDTH, 3 * ATT_WIDTH, 3 * ATT_WIDTH + SSM_WIDTH,
               3 * ATT_WIDTH + SSM_WIDTH + D_MODEL], axis=-1)
    q = q.reshape(bsz, s, N_HEADS, HEAD_DIM)
    k = k.reshape(bsz, s, N_HEADS, HEAD_DIM)
    v = v.reshape(bsz, s, N_HEADS, HEAD_DIM)

    slopes = _alibi_slopes()
    outs, lses = [], []
    for window, dilation in PATTERNS:
        o, lse = _dilated_window_attention(q, k, v, slopes, window, dilation)
        outs.append(o)
        lses.append(lse)
    wts = jax.nn.softmax(jnp.stack(lses, axis=0), axis=0)
    o_att = jnp.sum(wts[..., None] * jnp.stack(outs, axis=0), axis=0)
    o_att = o_att.reshape(bsz, s, ATT_WIDTH).astype(u.dtype)
    y_att = o_att @ w_proj_att

    y_ssm = _s5_branch(us, a_re, a_im, log_dt, b_re, b_im, c_re, c_im,
                       d_skip, w_glu, b_glu) @ w_proj_ssm

    gb_att, gb_ssm = jnp.split(b_gate, 2, axis=-1)
    merged = jax.nn.sigmoid(g_att + gb_att) * y_att + jax.nn.sigmoid(g_ssm + gb_ssm) * y_ssm
    return merged @ w_out


def _conv_ffn(u, w_up, w_conv, b_conv, w_down):
    s = u.shape[1]
    a, val = jnp.split(u @ w_up, 2, axis=-1)
    ap = jnp.pad(a, ((0, 0), (CONV_W - 1, 0), (0, 0)))
    conv = b_conv
    for j in range(CONV_W):
        conv = conv + w_conv[j] * ap[:, CONV_W - 1 - j:CONV_W - 1 - j + s]
    return (jax.nn.silu(conv) * val) @ w_down


def setup_inputs(seed: int = 0) -> dict:
    key = jax.random.key(seed)
    ks = jax.random.split(key, 32)
    f32 = jnp.float32
    L, D, G, N, C = DEPTH, D_MODEL, SSM_GROUPS, SSM_STATE, SSM_GROUP_CH
    nrm = lambda k, shape, sc: jax.random.normal(k, shape, f32) * sc
    inp = {}
    inp["x"] = nrm(ks[0], (BATCH, SEQ, D), 1.0)
    inp["c"] = nrm(ks[1], (BATCH, D), 1.0)
    inp["w_ada"] = nrm(ks[2], (L, D, 6 * D), 0.5 * D ** -0.5)
    inp["b_ada"] = nrm(ks[3], (L, 6 * D), 0.02)
    inp["g_mix"] = 1.0 + nrm(ks[4], (L, D), 0.02)
    inp["w_in"] = nrm(ks[5], (L, D, IN_WIDTH), D ** -0.5)
    inp["b_gate"] = nrm(ks[6], (L, 2 * D), 0.02)
    inp["a_re"] = -0.5 + nrm(ks[7], (L, G, N), 0.01)
    inp["a_im"] = jnp.pi * jnp.arange(N, dtype=f32)[None, None, :] + nrm(ks[8], (L, G, N), 0.01)
    inp["log_dt"] = jax.random.uniform(ks[9], (L, G), f32, math.log(1e-3), math.log(1e-1))
    inp["b_re"] = nrm(ks[10], (L, G, N, C), (2 * C) ** -0.5)
    inp["b_im"] = nrm(ks[11], (L, G, N, C), (2 * C) ** -0.5)
    inp["c_re"] = nrm(ks[12], (L, G, C, N), (2 * N) ** -0.5)
    inp["c_im"] = nrm(ks[13], (L, G, C, N), (2 * N) ** -0.5)
    inp["d_skip"] = nrm(ks[14], (L, SSM_WIDTH), 1.0)
    inp["w_glu"] = nrm(ks[15], (L, SSM_WIDTH, SSM_WIDTH), SSM_WIDTH ** -0.5)
    inp["b_glu"] = nrm(ks[16], (L, SSM_WIDTH), 0.02)
    inp["w_proj_att"] = nrm(ks[17], (L, ATT_WIDTH, D), ATT_WIDTH ** -0.5)
    inp["w_proj_ssm"] = nrm(ks[18], (L, SSM_WIDTH, D), SSM_WIDTH ** -0.5)
    inp["w_out"] = nrm(ks[19], (L, D, D), D ** -0.5)
    inp["g_ffn"] = 1.0 + nrm(ks[20], (L, D), 0.02)
    inp["w_up"] = nrm(ks[21], (L, D, 2 * D_FF), D ** -0.5)
    inp["w_conv"] = nrm(ks[22], (L, CONV_W, D_FF), CONV_W ** -0.5)
    inp["b_conv"] = nrm(ks[23], (L, D_FF), 0.02)
    inp["w_down"] = nrm(ks[24], (L, D_FF, D), D_FF ** -0.5)
    inp["g_final"] = 1.0 + nrm(ks[25], (D,), 0.02)
    return inp


def reference(x, c, w_ada, b_ada, g_mix, w_in, b_gate, a_re, a_im, log_dt, b_re, b_im,
              c_re, c_im, d_skip, w_glu, b_glu, w_proj_att, w_proj_ssm, w_out,
              g_ffn, w_up, w_conv, b_conv, w_down, g_final):
    h = x
    c_act = jax.nn.silu(c)
    for l in range(DEPTH):
        mod = c_act @ w_ada[l] + b_ada[l]
        sh1, sc1, gt1, sh2, sc2, gt2 = jnp.split(mod, 6, axis=-1)
        u = _modulate(h, g_mix[l], sh1, sc1)
        h = h + gt1[:, None, :] * _hybrid_mixer(
            u, w_in[l], b_gate[l], a_re[l], a_im[l], log_dt[l], b_re[l], b_im[l],
            c_re[l], c_im[l], d_skip[l], w_glu[l], b_glu[l],
            w_proj_att[l], w_proj_ssm[l], w_out[l])
        u = _modulate(h, g_ffn[l], sh2, sc2)
        h = h + gt2[:, None, :] * _conv_ffn(u, w_up[l], w_conv[l], b_conv[l], w_down[l])
    return _rmsnorm(h, g_final)
```

```cpp
#include <hip/hip_runtime.h>
#include <hip/hip_cooperative_groups.h>
#include <cstdio>
#include <cstdint>
namespace cg = cooperative_groups;

#ifndef MK_SINGLE
#define MK_SINGLE 1
#endif

#ifndef PROBE_MASK
#define PROBE_MASK 0x000
#endif
#ifndef PROBE_REPS
#define PROBE_REPS 1
#endif
#define LAS __attribute__((address_space(3)))
#define GAS __attribute__((address_space(1)))
typedef unsigned short bf16_t;
typedef short bf16x8 __attribute__((ext_vector_type(8)));
typedef float f32x4 __attribute__((ext_vector_type(4)));
typedef unsigned u32x4 __attribute__((ext_vector_type(4)));
typedef unsigned u32x2 __attribute__((ext_vector_type(2)));

constexpr int DM = 1024, NBATCH = 32, SEQ = 2048, M = NBATCH * SEQ, NH = 8, HD = 64, AW = 512, SW = 256;
constexpr int SG = 16, SC = 16, SN = 64, FF = 2048, INW = 3840, TCH = 64  , NCH = SEQ / TCH  ;
constexpr int KX = TCH * SC + 2 * SN;
constexpr float LOG2E = 1.4426950408889634f;
constexpr float QSCALE = 0.125f * LOG2E;
constexpr float EPS = 1e-6f;
constexpr int NWAVES = 8, NTHR = 512;

constexpr size_t MiB = 1u << 20;
constexpr size_t WS_MOD = 1 * MiB;
constexpr size_t WS_KS = 2 * MiB;
constexpr size_t WS_ATC = 3 * MiB;
constexpr size_t WS_WIN = 4 * MiB;
constexpr size_t WS_WPA = 12 * MiB;
constexpr size_t WS_WPS = 13 * MiB;
constexpr size_t WS_WGLU = 13 * MiB + 512 * 1024;
constexpr size_t WS_WOUT = 14 * MiB;
constexpr size_t WS_WUP = 16 * MiB;
constexpr size_t WS_WDN = 24 * MiB;
constexpr size_t WS_WST = 28 * MiB;
constexpr size_t WS_KW = 36 * MiB;
constexpr size_t WS_SLOC = 72 * MiB;
constexpr size_t WS_LSE = 80 * MiB;
constexpr size_t WS_MODE = 3 * MiB + 65536;
constexpr size_t WS_PW = 88 * MiB;
constexpr size_t WS_SLOC4 = 96 * MiB;
constexpr size_t WS_XN = 96 * MiB;
constexpr size_t WS_QKV = 708 * MiB;
constexpr size_t WS_OATT = 224 * MiB;
constexpr size_t WS_Y2 = 320 * MiB;
constexpr size_t WS_YG = 320 * MiB;
constexpr size_t WS_GATES = 416 * MiB;
constexpr size_t WS_UX = 672 * MiB;
constexpr size_t WS_OP = 708 * MiB;
constexpr size_t WS_HB = 544 * MiB;
constexpr size_t WS_SSQ = 72 * MiB;
constexpr size_t WS_SHW = 90 * MiB;
constexpr size_t WS_HBF = 708 * MiB;
constexpr size_t WS_XCH = 91 * MiB;
constexpr size_t WS_CNT = 4096;
constexpr size_t WS_UP = 224 * MiB;
constexpr size_t WS_END = 900 * MiB;

__device__ __forceinline__ unsigned cvt_pk_bf16(float lo, float hi) { unsigned r; asm volatile("v_cvt_pk_bf16_f32 %0, %1, %2" : "=v"(r) : "v"(lo), "v"(hi)); return r; }
__device__ __forceinline__ float bf_lo(unsigned w) { return __builtin_bit_cast(float, w << 16); }
__device__ __forceinline__ float bf_hi(unsigned w) { return __builtin_bit_cast(float, w & 0xffff0000u); }
__device__ __forceinline__ float sigmoidf_(float x) { return __builtin_amdgcn_rcpf(1.f + __builtin_amdgcn_exp2f(-x * LOG2E)); }
__device__ __forceinline__ u32x4 pack8(const float* v) { u32x4 w; w.x = cvt_pk_bf16(v[0], v[1]); w.y = cvt_pk_bf16(v[2], v[3]); w.z = cvt_pk_bf16(v[4], v[5]); w.w = cvt_pk_bf16(v[6], v[7]); return w; }
__device__ __forceinline__ void unpack8(u32x4 w, float* v) { v[0] = bf_lo(w.x); v[1] = bf_hi(w.x); v[2] = bf_lo(w.y); v[3] = bf_hi(w.y); v[4] = bf_lo(w.z); v[5] = bf_hi(w.z); v[6] = bf_lo(w.w); v[7] = bf_hi(w.w); }
__device__ __forceinline__ float wave_sum(float v) {
#pragma unroll
    for (int o = 1; o < 64; o <<= 1) v += __shfl_xor(v, o);
    return v;
}

namespace pg8 {
constexpr int BM = 256, BK = 64, HALF = 128, HTB = HALF * BK * 2, STAGE_BYTES = 8 * HTB, NXCD = 8, WGM = 8;
__host__ __device__ __forceinline__ int lds_byte(int r, int c) { const int st = (r >> 4) * 2 + (c >> 5), rr = r & 15, cc = c & 31, ob = rr * 64 + cc * 2; return st * 1024 + (ob ^ (((ob >> 9) & 1) << 5)); }
__host__ __device__ __forceinline__ void stage_rc(int b, int& R, int& C) { const int st = b / 1024, sb = b % 1024, swz = sb ^ (((sb >> 9) & 1) << 5); R = (st >> 1) * 16 + swz / 64; C = (st & 1) * 32 + (swz % 64) / 2; }
__host__ __device__ __forceinline__ int perm32(int rho) { const int n = rho >> 4, i = rho & 15; return 8 * (i >> 2) + 4 * n + (i & 3); }

struct Unit { int pm, pn; };
struct Gemm { const bf16_t* A; const bf16_t* Bt; int lda, ldb, K; };

struct StaticOrder {
    int nM, nN, nwg, G, c;
    __device__ void init(int M_, int N_, int G_, int c_) { nM = M_ / BM; nN = N_ / BM; nwg = nM * nN; G = G_; c = c_; }
    __device__ bool next(int i, Unit& u) const {
        const long L = (long)i * G + c; if (L >= nwg) return false;
        int wgid = (int)L; { const int q = nwg / NXCD, r = nwg % NXCD, xcd = wgid % NXCD, off = wgid / NXCD; wgid = (xcd < r ? xcd * (q + 1) : r * (q + 1) + (xcd - r) * q) + off; }
        const int nig = WGM * nN, gid = wgid / nig, fm = gid * WGM, gsz = (nM - fm) < WGM ? (nM - fm) : WGM;
        u.pm = fm + ((wgid % nig) % gsz); u.pn = (wgid % nig) / gsz; return true;
    }
};
struct SchedS1 { int c; __device__ bool next(int i, Unit& u) const { if (i > 0) return false; const int L = c >> 2; u.pm = L; u.pn = L >> 2; return true; } };
struct SchedS3 { int G, c; __device__ bool next(int i, Unit& u) const { const int L = i * G + c; if (L >= 256) return false; const int g = L >> 4; u.pm = g * 4 + ((L >> 2) & 3); u.pn = g * 4 + (L & 3); return true; } };

#define EPI_BEGIN \
    _Pragma("unroll") for (int ai = 0; ai < 2; ++ai) _Pragma("unroll") for (int m = 0; m < 4; ++m) { const int row = u.pm * 256 + ai * 128 + wr * 64 + m * 16 + fr; \
    _Pragma("unroll") for (int bj = 0; bj < 2; ++bj) { const int col = u.pn * 256 + bj * 128 + wc * 32 + 8 * fq; \
        float v[8]; { const f32x4 v0 = acc[ai][bj][m][0], v1 = acc[ai][bj][m][1]; v[0] = v0[0]; v[1] = v0[1]; v[2] = v0[2]; v[3] = v0[3]; v[4] = v1[0]; v[5] = v1[1]; v[6] = v1[2]; v[7] = v1[3]; }
#define EPI_END } }
#define EPI_ARGS const f32x4 (&acc)[2][2][4][2], const Unit& u, int wr, int wc, int fr, int fq

struct EpiInProj {
    bf16_t* QKV; bf16_t* UX; bf16_t* GATES; const float* b_gate;
    __device__ __forceinline__ void operator()(EPI_ARGS) const {
        const int pn = u.pn;
        if (pn < 6) { const float sc = pn < 2 ? QSCALE : 1.f;
            EPI_BEGIN
#pragma unroll
                for (int j = 0; j < 8; ++j) v[j] *= sc;
                { const int which = col >> 9, hh = (col >> 6) & 7, e0 = col & 63;
                  *(u32x4*)(QKV + (size_t)which * ((size_t)M * 512) + ((size_t)((row >> 11) * 8 + hh) * SEQ + (row & 2047)) * 64 + e0) = pack8(v); }
            EPI_END
        } else if (pn == 6) {
            EPI_BEGIN
                const int lc = col - 1536, g = lc >> 4, c8 = lc & 15, b = row >> 11, t = row & 2047;
                *(u32x4*)(UX + (size_t)(g * 1024 + b * NCH + (t >> 6)) * KX + (t & 63) * 16 + c8) = pack8(v);
            EPI_END
        } else {
            EPI_BEGIN
                const int gc = col - 1792; const f32x4 b0 = *(const f32x4*)(b_gate + gc), b1 = *(const f32x4*)(b_gate + gc + 4);
                v[0] = sigmoidf_(v[0] + b0[0]); v[1] = sigmoidf_(v[1] + b0[1]); v[2] = sigmoidf_(v[2] + b0[2]); v[3] = sigmoidf_(v[3] + b0[3]);
                v[4] = sigmoidf_(v[4] + b1[0]); v[5] = sigmoidf_(v[5] + b1[1]); v[6] = sigmoidf_(v[6] + b1[2]); v[7] = sigmoidf_(v[7] + b1[3]);
                *(u32x4*)(GATES + (size_t)row * 2048 + gc) = pack8(v);
            EPI_END
        }
    }
};
struct EpiS1 {
    float* SLOC;
    __device__ __forceinline__ void operator()(EPI_ARGS) const {
        EPI_BEGIN
            if (bj == 0) { const int lc = col & 255; float* d = SLOC + (size_t)row * 128 + lc; *(f32x4*)d = (f32x4){v[0], v[1], v[2], v[3]}; *(f32x4*)(d + 4) = (f32x4){v[4], v[5], v[6], v[7]}; }
        EPI_END
    }
};
struct EpiS3 {
    const bf16_t* UX; const float* d_skip; bf16_t* Y2;
    __device__ __forceinline__ void operator()(EPI_ARGS) const {
        EPI_BEGIN
            const int g = row >> 10, bc = row & 1023, lc = col & 1023, i = lc >> 4, c8 = lc & 15;
            float uu[8]; unpack8(*(const u32x4*)(UX + (size_t)row * KX + lc), uu);
            const f32x4 d0 = *(const f32x4*)(d_skip + g * 16 + c8), d1 = *(const f32x4*)(d_skip + g * 16 + c8 + 4);
            const float dd[8] = {d0[0], d0[1], d0[2], d0[3], d1[0], d1[1], d1[2], d1[3]};
#pragma unroll
            for (int j = 0; j < 8; ++j) { const float y = v[j] + dd[j] * uu[j]; v[j] = y * sigmoidf_(1.5957691216057308f * (y + 0.044715f * y * y * y)); }
            *(u32x4*)(Y2 + (size_t)(bc * 64 + i) * 256 + g * 16 + c8) = pack8(v);
        EPI_END
    }
};
struct EpiGlu {
    const bf16_t* Y2; const float* b_glu; bf16_t* YG;
    __device__ __forceinline__ void operator()(EPI_ARGS) const {
        EPI_BEGIN
            float y[8]; unpack8(*(const u32x4*)(Y2 + (size_t)row * 256 + col), y);
            const f32x4 b0 = *(const f32x4*)(b_glu + col), b1 = *(const f32x4*)(b_glu + col + 4);
            const float bb[8] = {b0[0], b0[1], b0[2], b0[3], b1[0], b1[1], b1[2], b1[3]};
#pragma unroll
            for (int j = 0; j < 8; ++j) v[j] = y[j] * sigmoidf_(v[j] + bb[j]);
            *(u32x4*)(YG + (size_t)row * 768 + 512 + col) = pack8(v);
        EPI_END
    }
};
struct EpiMerge1 {
    const bf16_t* GATES; bf16_t* MG;
    __device__ __forceinline__ void mid(f32x4 (&acc)[2][2][4][2], const Unit& u, int wr, int wc, int fr, int fq) const {
        int pm_ = u.pm; asm volatile("" : "+s"(pm_));
        const bf16_t* gbase = GATES + (size_t)(pm_ * 256 + wr * 64 + fr) * 2048 + u.pn * 256 + wc * 32 + 8 * fq;
#pragma unroll
        for (int ai = 0; ai < 2; ++ai)
#pragma unroll
            for (int m = 0; m < 4; ++m) {
#pragma unroll
                for (int bj = 0; bj < 2; ++bj) { const bf16_t* gp = gbase + (size_t)(ai * 128 + m * 16) * 2048 + bj * 128;
                    float sa[8], ss[8]; unpack8(__builtin_nontemporal_load((const u32x4*)gp), sa); unpack8(*(const u32x4*)(gp + 1024), ss);
                    f32x4 r0, r1;
                    r0[0] = sa[0] * __builtin_amdgcn_rcpf(ss[0]); r0[1] = sa[1] * __builtin_amdgcn_rcpf(ss[1]); r0[2] = sa[2] * __builtin_amdgcn_rcpf(ss[2]); r0[3] = sa[3] * __builtin_amdgcn_rcpf(ss[3]);
                    r1[0] = sa[4] * __builtin_amdgcn_rcpf(ss[4]); r1[1] = sa[5] * __builtin_amdgcn_rcpf(ss[5]); r1[2] = sa[6] * __builtin_amdgcn_rcpf(ss[6]); r1[3] = sa[7] * __builtin_amdgcn_rcpf(ss[7]);
                    acc[ai][bj][m][0] = acc[ai][bj][m][0] * r0; acc[ai][bj][m][1] = acc[ai][bj][m][1] * r1; }
                __builtin_amdgcn_sched_barrier(0); }
    }
    __device__ __forceinline__ void operator()(EPI_ARGS) const {
        EPI_BEGIN
            float ss[8]; unpack8(__builtin_nontemporal_load((const u32x4*)(GATES + (size_t)row * 2048 + 1024 + col)), ss);
#pragma unroll
            for (int j = 0; j < 8; ++j) v[j] *= ss[j];
            *(u32x4*)(MG + (size_t)row * 1024 + col) = pack8(v);
        EPI_END
    }
};
template <int PASS> struct EpiMerge {
    const bf16_t* GATES; bf16_t* MG;
    __device__ __forceinline__ void operator()(EPI_ARGS) const {
        EPI_BEGIN
            float s[8]; unpack8(*(const u32x4*)(GATES + (size_t)row * 2048 + PASS * 1024 + col), s);
            bf16_t* d = MG + (size_t)row * 1024 + col;
            if (PASS == 1) { float o[8]; unpack8(*(const u32x4*)d, o);
#pragma unroll
                for (int j = 0; j < 8; ++j) v[j] = o[j] + s[j] * v[j];
            } else {
#pragma unroll
                for (int j = 0; j < 8; ++j) v[j] = s[j] * v[j];
            }
            *(u32x4*)d = pack8(v);
        EPI_END
    }
};
struct EpiRes {
    const float* base; const float* gate  ; float* out;
    __device__ __forceinline__ void operator()(EPI_ARGS) const {
        EPI_BEGIN
            const int b = row >> 11; const float* gp = gate + b * 6144 + col; const float* bp = base + (size_t)row * 1024 + col; float* op = out + (size_t)row * 1024 + col;
            const f32x4 g0 = *(const f32x4*)gp, g1 = *(const f32x4*)(gp + 4), x0 = *(const f32x4*)bp, x1 = *(const f32x4*)(bp + 4);
            *(f32x4*)op = (f32x4){x0[0] + g0[0] * v[0], x0[1] + g0[1] * v[1], x0[2] + g0[2] * v[2], x0[3] + g0[3] * v[3]};
            *(f32x4*)(op + 4) = (f32x4){x1[0] + g1[0] * v[4], x1[1] + g1[1] * v[5], x1[2] + g1[2] * v[6], x1[3] + g1[3] * v[7]};
        EPI_END
    }
};
struct SchedChain { int c; __device__ bool next(int i, Unit& u) const { if (i >= 16) return false; const int xx = c & 7, k = c >> 3, round = i >> 3, step = i & 7; u.pm = 8 * (4 * xx + (k >> 3)) + step; u.pn = (k & 7) + 8 * round; return true; } };
__device__ __forceinline__ float dpp_ror1(float v) { return __builtin_bit_cast(float, __builtin_amdgcn_update_dpp(__builtin_bit_cast(int, v), __builtin_bit_cast(int, v), 0x121, 0xf, 0xf, false)); }
__device__ __forceinline__ float dpp_ror2(float v) { return __builtin_bit_cast(float, __builtin_amdgcn_update_dpp(__builtin_bit_cast(int, v), __builtin_bit_cast(int, v), 0x122, 0xf, 0xf, false)); }
struct EpiUpConv {
    bf16_t* ACT; const float* w_conv; const float* b_conv; LAS float* xb;
    const float* SSQp; const float* SHWp;
    __device__ __forceinline__ void operator()(f32x4 (&acc)[2][2][4][2], const Unit& u, int wr, int wc, int fr, int fq) const {
        const int colb = wc * 32 + 8 * fq, step = u.pm & 7, par = step & 1;
        { const float* sp = SHWp + (u.pm >> 3) * 4096 + u.pn * 256 + colb; const f32x4 sa0 = *(const f32x4*)sp, sa1 = *(const f32x4*)(sp + 4), sv0 = *(const f32x4*)(sp + 128), sv1 = *(const f32x4*)(sp + 132);
#pragma unroll
          for (int ai = 0; ai < 2; ++ai)
#pragma unroll
              for (int m = 0; m < 4; ++m) { const int row = u.pm * 256 + ai * 128 + wr * 64 + m * 16 + fr; const f32x4 q0 = *(const f32x4*)(SSQp + (size_t)row * 16 + 4 * fq);
                  float tot = (q0[0] + q0[1]) + (q0[2] + q0[3]); tot += __shfl_xor(tot, 16); tot += __shfl_xor(tot, 32);
                  const float rstd = 1.f / sqrtf(tot * (1.f / DM) + EPS);
                  acc[ai][0][m][0] = acc[ai][0][m][0] * rstd + sa0; acc[ai][0][m][1] = acc[ai][0][m][1] * rstd + sa1;
                  acc[ai][1][m][0] = acc[ai][1][m][0] * rstd + sv0; acc[ai][1][m][1] = acc[ai][1][m][1] * rstd + sv1; } }
#pragma unroll
        for (int ai = 0; ai < 2; ++ai) { const int slot = (ai == 0) ? wr : (wr == 0 ? 2 : 4 + par);
            if (fr >= 14) { LAS float* d = xb + (slot * 2 + (fr - 14)) * 128 + colb; *(LAS f32x4*)d = acc[ai][0][3][0]; *(LAS f32x4*)(d + 4) = acc[ai][0][3][1]; } }
        asm volatile("s_waitcnt lgkmcnt(0)" ::: "memory"); __builtin_amdgcn_s_barrier(); asm volatile("" ::: "memory");
        float w0[8], w1[8], w2[8], bc[8];
        { const int j0 = u.pn * 128 + colb;
#pragma unroll
          for (int j = 0; j < 8; ++j) { w0[j] = w_conv[j0 + j]; w1[j] = w_conv[FF + j0 + j]; w2[j] = w_conv[2 * FF + j0 + j]; bc[j] = b_conv[j0 + j]; } }
#pragma unroll
        for (int ai = 0; ai < 2; ++ai) {
            float prev[8];
            { const int src = (ai == 0) ? (wr == 0 ? 4 + (par ^ 1) : 0) : (wr == 0 ? 1 : 2); const bool zero = (ai == 0) && (wr == 0) && (step == 0);
              const LAS float* p = xb + (src * 2 + (fr & 1)) * 128 + colb; const f32x4 p0 = *(const LAS f32x4*)p, p1 = *(const LAS f32x4*)(p + 4);
              prev[0] = zero ? 0.f : p0[0]; prev[1] = zero ? 0.f : p0[1]; prev[2] = zero ? 0.f : p0[2]; prev[3] = zero ? 0.f : p0[3];
              prev[4] = zero ? 0.f : p1[0]; prev[5] = zero ? 0.f : p1[1]; prev[6] = zero ? 0.f : p1[2]; prev[7] = zero ? 0.f : p1[3]; }
#pragma unroll
            for (int m = 0; m < 4; ++m) { const int row = u.pm * 256 + ai * 128 + wr * 64 + m * 16 + fr;
                float cur[8], vv[8], o[8];
                { const f32x4 a0 = acc[ai][0][m][0], a1 = acc[ai][0][m][1], v0 = acc[ai][1][m][0], v1 = acc[ai][1][m][1];
                  cur[0] = a0[0]; cur[1] = a0[1]; cur[2] = a0[2]; cur[3] = a0[3]; cur[4] = a1[0]; cur[5] = a1[1]; cur[6] = a1[2]; cur[7] = a1[3];
                  vv[0] = v0[0]; vv[1] = v0[1]; vv[2] = v0[2]; vv[3] = v0[3]; vv[4] = v1[0]; vv[5] = v1[1]; vv[6] = v1[2]; vv[7] = v1[3]; }
#pragma unroll
                for (int j = 0; j < 8; ++j) { const float r1 = dpp_ror1(cur[j]), q1 = dpp_ror1(prev[j]), r2 = dpp_ror2(cur[j]), q2 = dpp_ror2(prev[j]);
                    const float a1 = (fr == 0) ? q1 : r1, a2 = (fr < 2) ? q2 : r2;
                    const float cv = bc[j] + w0[j] * cur[j] + w1[j] * a1 + w2[j] * a2; o[j] = cv * sigmoidf_(cv) * vv[j]; prev[j] = cur[j]; }
                *(u32x4*)(ACT + (size_t)row * FF + u.pn * 128 + colb) = pack8(o); }
        }
    }
};
struct EpiResNorm {
    const float* base; const float* MODp; const float* g_ffn; bf16_t* Hbf; bf16_t* HBp; float* SSQp;
    __device__ __forceinline__ void operator()(EPI_ARGS) const {
#pragma unroll
        for (int ai = 0; ai < 2; ++ai)
#pragma unroll
            for (int m = 0; m < 4; ++m) { const int row = u.pm * 256 + ai * 128 + wr * 64 + m * 16 + fr, b = row >> 11; float ss = 0.f;
#pragma unroll
                for (int bj = 0; bj < 2; ++bj) { const int col = u.pn * 256 + bj * 128 + wc * 32 + 8 * fq;
                    const f32x4 v0 = acc[ai][bj][m][0], v1 = acc[ai][bj][m][1];
                    const float* mp = MODp + b * 6144 + col; const float* bp = base + (size_t)row * 1024 + col;
                    const f32x4 g0 = *(const f32x4*)(mp + 2048), g1 = *(const f32x4*)(mp + 2048 + 4), x0 = __builtin_nontemporal_load((const f32x4*)bp), x1 = __builtin_nontemporal_load((const f32x4*)(bp + 4));
                    const f32x4 s0 = *(const f32x4*)(mp + 4096), s1 = *(const f32x4*)(mp + 4096 + 4), f0 = *(const f32x4*)(g_ffn + col), f1 = *(const f32x4*)(g_ffn + col + 4);
                    float h[8] = {x0[0] + g0[0] * v0[0], x0[1] + g0[1] * v0[1], x0[2] + g0[2] * v0[2], x0[3] + g0[3] * v0[3], x1[0] + g1[0] * v1[0], x1[1] + g1[1] * v1[1], x1[2] + g1[2] * v1[2], x1[3] + g1[3] * v1[3]};
                    *(u32x4*)(Hbf + (size_t)row * 1024 + col) = pack8(h);
#pragma unroll
                    for (int j = 0; j < 8; ++j) ss += h[j] * h[j];
                    const float gmv[8] = {f0[0] * (1.f + s0[0]), f0[1] * (1.f + s0[1]), f0[2] * (1.f + s0[2]), f0[3] * (1.f + s0[3]), f1[0] * (1.f + s1[0]), f1[1] * (1.f + s1[1]), f1[2] * (1.f + s1[2]), f1[3] * (1.f + s1[3])};
#pragma unroll
                    for (int j = 0; j < 8; ++j) h[j] *= gmv[j];
                    *(u32x4*)(HBp + (size_t)row * 1024 + col) = pack8(h); }
                ss += __shfl_xor(ss, 16); ss += __shfl_xor(ss, 32);
                if (fq == 0) SSQp[(size_t)row * 16 + u.pn * 4 + wc] = ss; }
    }
};
struct EpiRes2 {
    const bf16_t* base; const float* gate  ; bf16_t* H2; float* SSQp;
    __device__ __forceinline__ void operator()(EPI_ARGS) const {
#pragma unroll
        for (int ai = 0; ai < 2; ++ai)
#pragma unroll
            for (int m = 0; m < 4; ++m) { const int row = u.pm * 256 + ai * 128 + wr * 64 + m * 16 + fr, b = row >> 11; float ss = 0.f;
#pragma unroll
                for (int bj = 0; bj < 2; ++bj) { const int col = u.pn * 256 + bj * 128 + wc * 32 + 8 * fq;
                    const f32x4 v0 = acc[ai][bj][m][0], v1 = acc[ai][bj][m][1];
                    const float* gp = gate + b * 6144 + col; float xb[8]; unpack8(*(const u32x4*)(base + (size_t)row * 1024 + col), xb);
                    const f32x4 g0 = *(const f32x4*)gp, g1 = *(const f32x4*)(gp + 4);
                    float h[8] = {xb[0] + g0[0] * v0[0], xb[1] + g0[1] * v0[1], xb[2] + g0[2] * v0[2], xb[3] + g0[3] * v0[3], xb[4] + g1[0] * v1[0], xb[5] + g1[1] * v1[1], xb[6] + g1[2] * v1[2], xb[7] + g1[3] * v1[3]};
#pragma unroll
                    for (int j = 0; j < 8; ++j) ss += h[j] * h[j];
                    *(u32x4*)(H2 + (size_t)row * 1024 + col) = pack8(h); }
                ss += __shfl_xor(ss, 16); ss += __shfl_xor(ss, 32);
                if (fq == 0) SSQp[(size_t)row * 16 + u.pn * 4 + wc] = ss; }
    }
};
struct EpiResFinal {
    const bf16_t* base; const float* gate  ; const float* g_final; float* out; float* XCH; unsigned* CNT; LAS float* misc;
    __device__ __forceinline__ void operator()(f32x4 (&acc)[2][2][4][2], const Unit& u, int wr, int wc, int fr, int fq) const {
        const int tid = (wr * 4 + wc) * 64 + fq * 16 + fr;
        LAS float* part = misc; LAS float* rs = misc + 1024;
#pragma unroll
        for (int ai = 0; ai < 2; ++ai)
#pragma unroll
            for (int m = 0; m < 4; ++m) { const int rl = ai * 128 + wr * 64 + m * 16 + fr, row = u.pm * 256 + rl, b = row >> 11; float ss = 0.f;
#pragma unroll
                for (int bj = 0; bj < 2; ++bj) { const int col = u.pn * 256 + bj * 128 + wc * 32 + 8 * fq;
                    const float* gp = gate + b * 6144 + col; float xb[8]; unpack8(__builtin_nontemporal_load((const u32x4*)(base + (size_t)row * 1024 + col)), xb);
                    const f32x4 g0 = *(const f32x4*)gp, g1 = *(const f32x4*)(gp + 4); f32x4 h0, h1;
                    h0[0] = xb[0] + g0[0] * acc[ai][bj][m][0][0]; h0[1] = xb[1] + g0[1] * acc[ai][bj][m][0][1]; h0[2] = xb[2] + g0[2] * acc[ai][bj][m][0][2]; h0[3] = xb[3] + g0[3] * acc[ai][bj][m][0][3];
                    h1[0] = xb[4] + g1[0] * acc[ai][bj][m][1][0]; h1[1] = xb[5] + g1[1] * acc[ai][bj][m][1][1]; h1[2] = xb[6] + g1[2] * acc[ai][bj][m][1][2]; h1[3] = xb[7] + g1[3] * acc[ai][bj][m][1][3];
                    ss += (h0[0] * h0[0] + h0[1] * h0[1]) + (h0[2] * h0[2] + h0[3] * h0[3]) + (h1[0] * h1[0] + h1[1] * h1[1]) + (h1[2] * h1[2] + h1[3] * h1[3]);
                    acc[ai][bj][m][0] = h0; acc[ai][bj][m][1] = h1; }
                ss += __shfl_xor(ss, 16); ss += __shfl_xor(ss, 32);
                if (fq == 0) part[wc * 256 + rl] = ss; }
        asm volatile("s_waitcnt lgkmcnt(0)" ::: "memory"); __builtin_amdgcn_s_barrier(); asm volatile("" ::: "memory");
        if (tid < 256) { const float tot = (part[tid] + part[256 + tid]) + (part[512 + tid] + part[768 + tid]);
            __hip_atomic_store(XCH + (size_t)(u.pm * 4 + u.pn) * 256 + tid, tot, __ATOMIC_RELAXED, __HIP_MEMORY_SCOPE_AGENT); }
        asm volatile("s_waitcnt vmcnt(0)" ::: "memory"); __builtin_amdgcn_s_barrier(); asm volatile("" ::: "memory");
        if (tid == 0) { __hip_atomic_fetch_add(CNT + u.pm, 1u, __ATOMIC_RELAXED, __HIP_MEMORY_SCOPE_AGENT);
            while (__hip_atomic_load(CNT + u.pm, __ATOMIC_RELAXED, __HIP_MEMORY_SCOPE_AGENT) < 4u) __builtin_amdgcn_s_sleep(1); }
        asm volatile("s_waitcnt vmcnt(0)" ::: "memory"); __builtin_amdgcn_s_barrier(); asm volatile("" ::: "memory");
        if (tid < 256) { const float* xp = XCH + (size_t)(u.pm * 4) * 256 + tid;
            const float t0 = __hip_atomic_load(xp, __ATOMIC_RELAXED, __HIP_MEMORY_SCOPE_AGENT), t1 = __hip_atomic_load(xp + 256, __ATOMIC_RELAXED, __HIP_MEMORY_SCOPE_AGENT),
                        t2 = __hip_atomic_load(xp + 512, __ATOMIC_RELAXED, __HIP_MEMORY_SCOPE_AGENT), t3 = __hip_atomic_load(xp + 768, __ATOMIC_RELAXED, __HIP_MEMORY_SCOPE_AGENT);
            rs[tid] = 1.f / sqrtf(((t0 + t1) + (t2 + t3)) * (1.f / DM) + EPS); }
        asm volatile("s_waitcnt lgkmcnt(0)" ::: "memory"); __builtin_amdgcn_s_barrier(); asm volatile("" ::: "memory");
#pragma unroll
        for (int ai = 0; ai < 2; ++ai)
#pragma unroll
            for (int m = 0; m < 4; ++m) { const int rl = ai * 128 + wr * 64 + m * 16 + fr, row = u.pm * 256 + rl; const float r = rs[rl];
#pragma unroll
                for (int bj = 0; bj < 2; ++bj) { const int col = u.pn * 256 + bj * 128 + wc * 32 + 8 * fq; float* op = out + (size_t)row * 1024 + col;
                    const f32x4 f0 = *(const f32x4*)(g_final + col), f1 = *(const f32x4*)(g_final + col + 4);
                    *(f32x4*)op = acc[ai][bj][m][0] * r * f0; *(f32x4*)(op + 4) = acc[ai][bj][m][1] * r * f1; } }
    }
};
struct EpiUp {
    bf16_t* UP;
    __device__ __forceinline__ void operator()(EPI_ARGS) const {
        EPI_BEGIN
            *(u32x4*)(UP + (size_t)row * 4096 + col) = pack8(v);
        EPI_END
    }
};

template <class Epi, class Sched, int MID_T = -1>
__device__ __forceinline__ void gemm_phase(LAS unsigned char* lds, const Gemm g, const Sched& S, const Epi& E, const int wid, const int lane) {
    const int tid = wid * 64 + lane, wr = wid >> 2, wc = wid & 3, fr = lane & 15, fq = lane >> 4;
    const int K = g.K, nt = K / BK;
    unsigned voffA[2], voffB[2];
#pragma unroll
    for (int i = 0; i < 2; ++i) { int R, C; stage_rc(tid * 16 + i * 8192, R, C); const int Rb = (R & ~31) + perm32(R & 31);
        voffA[i] = (unsigned)(R * g.lda + C) * 2u; voffB[i] = (unsigned)(Rb * g.ldb + C) * 2u; }
    const size_t kstep = (size_t)(BK * 2);
    const size_t hA = (size_t)HALF * g.lda * 2, hB = (size_t)HALF * g.ldb * 2, tA = 2 * hA, tB = 2 * hB;
    const unsigned ldsw = (unsigned)wid * 1024u;
    const int aoff = lds_byte(wr * 64 + fr, fq * 8), boff = lds_byte(wc * 32 + fr, fq * 8);
#define PG8_SA(b, h) (((b) * 2 + (h)) * HTB)
#define PG8_SB(b, h) ((4 + (b) * 2 + (h)) * HTB)
#define PG8_STAGE(bufoff, gbase, voff) do { _Pragma("unroll") for (int _i = 0; _i < 2; ++_i) \
        __builtin_amdgcn_global_load_lds((const GAS unsigned*)((const char*)(gbase) + (voff)[_i]), (LAS unsigned*)(lds + (bufoff) + ldsw + _i * 8192), 16, 0, 0); } while (0)
#define PG8_LDA(dst, b, h) do { _Pragma("unroll") for (int m = 0; m < 4; ++m) _Pragma("unroll") for (int k = 0; k < 2; ++k) dst[m][k] = *(const LAS bf16x8*)(lds + PG8_SA(b, h) + aoff + m * 2048 + k * 1024); } while (0)
#define PG8_LDB(dst, b, h) do { _Pragma("unroll") for (int n = 0; n < 2; ++n) _Pragma("unroll") for (int k = 0; k < 2; ++k) dst[n][k] = *(const LAS bf16x8*)(lds + PG8_SB(b, h) + boff + n * 2048 + k * 1024); } while (0)
#define PG8_MMA(ai, bj, At, Bt) do { __builtin_amdgcn_s_setprio(1); _Pragma("unroll") for (int m = 0; m < 4; ++m) _Pragma("unroll") for (int n = 0; n < 2; ++n) _Pragma("unroll") for (int k = 0; k < 2; ++k) \
        acc[ai][bj][m][n] = __builtin_amdgcn_mfma_f32_16x16x32_bf16(Bt[n][k], At[m][k], acc[ai][bj][m][n], 0, 0, 0); __builtin_amdgcn_s_setprio(0); } while (0)
#define PG8_WAIT_V(n) asm volatile("s_waitcnt vmcnt(" #n ")" ::: "memory")
#define PG8_WAIT_L(n) asm volatile("s_waitcnt lgkmcnt(" #n ")" ::: "memory")
#define PG8_BAR __builtin_amdgcn_s_barrier()
#define PG8_SCHED __builtin_amdgcn_sched_barrier(0)
    Unit cur, nxt; int ui = 0;
    if (!S.next(0, cur)) return;
    f32x4 acc[2][2][4][2];
#pragma unroll
    for (int a = 0; a < 2; ++a)
#pragma unroll
        for (int b = 0; b < 2; ++b)
#pragma unroll
            for (int m = 0; m < 4; ++m)
#pragma unroll
                for (int n = 0; n < 2; ++n) acc[a][b][m][n] = (f32x4){0.f, 0.f, 0.f, 0.f};
    bf16x8 At[4][2], B0[2][2], B1[2][2];
    const char* cA = (const char*)g.A + (size_t)cur.pm * tA; const char* cB = (const char*)g.Bt + (size_t)cur.pn * tB;
    PG8_STAGE(PG8_SB(0, 0), cB, voffB); PG8_STAGE(PG8_SB(0, 1), cB + hB, voffB); PG8_STAGE(PG8_SA(0, 0), cA, voffA); PG8_STAGE(PG8_SA(0, 1), cA + hA, voffA);
    if (wr == 1) PG8_BAR;
    PG8_WAIT_V(2); PG8_BAR;
    PG8_STAGE(PG8_SB(1, 0), cB + kstep, voffB); PG8_STAGE(PG8_SA(1, 0), cA + kstep, voffA); PG8_STAGE(PG8_SB(1, 1), cB + hB + kstep, voffB);
    PG8_WAIT_V(6); PG8_BAR;
    for (;;) {
        const bool has_next = S.next(ui + 1, nxt);
        const char* nA = has_next ? (const char*)g.A + (size_t)nxt.pm * tA : cA; const char* nB = has_next ? (const char*)g.Bt + (size_t)nxt.pn * tB : cB;
        for (int t = 0; t < nt; t += 2) {
            const bool last = (t == nt - 2);
            if constexpr (MID_T >= 0) { if (t == MID_T) E.mid(acc, cur, wr, wc, fr, fq); }
            const char* a1 = cA + (size_t)(t + 1) * kstep;
            const char* a2 = last ? nA : cA + (size_t)(t + 2) * kstep; const char* b2 = last ? nB : cB + (size_t)(t + 2) * kstep;
            const char* a3 = a2 + kstep; const char* b3 = b2 + kstep;
            PG8_LDB(B0, 0, 0); PG8_LDB(B1, 0, 1); PG8_SCHED; PG8_LDA(At, 0, 0); PG8_STAGE(PG8_SA(1, 1), a1 + hA, voffA);
            PG8_WAIT_V(8); PG8_WAIT_L(0); PG8_BAR; PG8_MMA(0, 0, At, B0); PG8_MMA(0, 1, At, B1); PG8_BAR; PG8_SCHED;
            PG8_LDA(At, 0, 1); PG8_STAGE(PG8_SB(0, 0), b2, voffB); PG8_STAGE(PG8_SB(0, 1), b2 + hB, voffB); PG8_STAGE(PG8_SA(0, 0), a2, voffA);
            PG8_WAIT_V(8); PG8_WAIT_L(0); PG8_BAR; PG8_MMA(1, 0, At, B0); PG8_MMA(1, 1, At, B1); PG8_BAR; PG8_SCHED;
            PG8_LDB(B0, 1, 0); PG8_LDB(B1, 1, 1); PG8_SCHED; PG8_LDA(At, 1, 0); PG8_STAGE(PG8_SA(0, 1), a2 + hA, voffA);
            PG8_WAIT_V(8); PG8_WAIT_L(0); PG8_BAR; PG8_MMA(0, 0, At, B0); PG8_MMA(0, 1, At, B1); PG8_BAR; PG8_SCHED;
            PG8_LDA(At, 1, 1); PG8_STAGE(PG8_SB(1, 0), b3, voffB); PG8_STAGE(PG8_SB(1, 1), b3 + hB, voffB); PG8_STAGE(PG8_SA(1, 0), a3, voffA);
            PG8_WAIT_V(8); PG8_WAIT_L(0); PG8_BAR; PG8_MMA(1, 0, At, B0); PG8_MMA(1, 1, At, B1); PG8_BAR; PG8_SCHED;
        }
        if (wr == 0) PG8_BAR;
        E(acc, cur, wr, wc, fr, fq);
        if (!has_next) break;
#pragma unroll
        for (int a = 0; a < 2; ++a)
#pragma unroll
            for (int b = 0; b < 2; ++b)
#pragma unroll
                for (int m = 0; m < 4; ++m)
#pragma unroll
                    for (int n = 0; n < 2; ++n) acc[a][b][m][n] = (f32x4){0.f, 0.f, 0.f, 0.f};
        cur = nxt; cA = nA; cB = nB; ++ui;
        if (wr == 1) PG8_BAR;
    }
    PG8_WAIT_V(0);
    PG8_BAR;
#undef PG8_SA
#undef PG8_SB
#undef PG8_STAGE
#undef PG8_LDA
#undef PG8_LDB
#undef PG8_MMA
#undef PG8_WAIT_V
#undef PG8_WAIT_L
#undef PG8_BAR
#undef PG8_SCHED
}
}

struct Args { const float* in[26]; float* out; unsigned char* ws; int ph_lo, ph_hi, pad0, pad1; };

__device__ __forceinline__ void transpose_item(const float* W, int K, int N, bf16_t* WT, LAS float* scr, int item, int lane, bool perm_up = false, int ldw = 0, int koff = 0) {
    if (ldw == 0) ldw = K;
    const int nblk = N / 32, kb = item / nblk, nb = item % nblk, k0 = 64 * kb, n0 = 32 * nb;
    float tv[32];
#pragma unroll
    for (int i = 0; i < 32; ++i) tv[i] = W[(size_t)(k0 + 2 * i + (lane >> 5)) * N + n0 + (lane & 31)];
#pragma unroll
    for (int i = 0; i < 32; ++i) scr[(2 * i + (lane >> 5)) * 33 + (lane & 31)] = tv[i];
    asm volatile("s_waitcnt lgkmcnt(0)" ::: "memory");
    const int c = lane & 7;
#pragma unroll
    for (int j = 0; j < 4; ++j) { const int n = (lane >> 3) + 8 * j; const LAS float* s = scr + (8 * c) * 33 + n;
        u32x4 o; o.x = cvt_pk_bf16(s[0 * 33], s[1 * 33]); o.y = cvt_pk_bf16(s[2 * 33], s[3 * 33]); o.z = cvt_pk_bf16(s[4 * 33], s[5 * 33]); o.w = cvt_pk_bf16(s[6 * 33], s[7 * 33]);
        int nn = n0 + n; if (perm_up) nn = (nn < FF) ? ((nn >> 7) * 256 + (nn & 127)) : (((nn - FF) >> 7) * 256 + 128 + ((nn - FF) & 127));
        *(u32x4*)(WT + (size_t)nn * ldw + koff + k0 + 8 * c) = o; }
    asm volatile("s_waitcnt lgkmcnt(0)" ::: "memory");
}

template <bool SILU, bool PERM_UP>
__device__ __forceinline__ void gemv32(LAS unsigned char* lds, const float* IN, int in_pitch, const float* W, int N, int c0, const float* bias, float* OUT, int out_pitch, int tid, int wave, int lane) {
    LAS float* cact = (LAS float*)lds;
    for (int i0 = tid; i0 < NBATCH * DM; i0 += 16 * NTHR) { float t[16];
#pragma unroll
        for (int k = 0; k < 16; ++k) { const int i = i0 + k * NTHR; t[k] = IN[(i >> 10) * in_pitch + (i & 1023)]; }
#pragma unroll
        for (int k = 0; k < 16; ++k) { const int i = i0 + k * NTHR; cact[(i >> 10) * 1025 + (i & 1023)] = SILU ? t[k] * sigmoidf_(t[k]) : t[k]; } }
    __syncthreads();
    typedef float f32x16 __attribute__((ext_vector_type(16)));
    f32x16 macc;
#pragma unroll
    for (int i = 0; i < 16; ++i) macc[i] = 0.f;
    const int kb = wave * 128 + (lane >> 5), cl = lane & 31;
    const float* wp = W + (size_t)kb * N + c0 + cl; const LAS float* cp = cact + cl * 1025 + kb;
    for (int k0 = 0; k0 < 64; k0 += 16) { float wv[16], cv[16];
#pragma unroll
        for (int kk = 0; kk < 16; ++kk) { wv[kk] = wp[(size_t)(k0 + kk) * 2 * N]; cv[kk] = cp[(k0 + kk) * 2]; }
#pragma unroll
        for (int kk = 0; kk < 16; ++kk) macc = __builtin_amdgcn_mfma_f32_32x32x2f32(cv[kk], wv[kk], macc, 0, 0, 0); }
    __syncthreads();
    LAS float* red = (LAS float*)lds;
#pragma unroll
    for (int i = 0; i < 16; ++i) red[(wave * 16 + i) * 64 + lane] = macc[i];
    __syncthreads();
    for (int o = tid; o < 1024; o += NTHR) { float s = 0.f;
#pragma unroll
        for (int w8 = 0; w8 < 8; ++w8) s += red[w8 * 1024 + o];
        const int i = o >> 6, l = o & 63, b = (i & 3) + 8 * (i >> 2) + 4 * (l >> 5), cc = c0 + (l & 31);
        int oc = cc; if (PERM_UP) oc = (cc < FF) ? ((cc >> 7) * 256 + (cc & 127)) : (((cc - FF) >> 7) * 256 + 128 + ((cc - FF) & 127));
        OUT[b * out_pitch + oc] = s + (bias ? bias[cc] : 0.f); }
    __syncthreads();
}

struct cplx { double re, im; };
__device__ __forceinline__ cplx cmul(cplx a, cplx b) { return cplx{a.re * b.re - a.im * b.im, a.re * b.im + a.im * b.re}; }
__device__ __forceinline__ cplx cpow_int(cplx a, int e) { cplx r{1.0, 0.0};
    while (e > 0) { if (e & 1) r = cmul(r, a); a = cmul(a, a); e >>= 1; } return r; }
__device__ __forceinline__ double dexp(double x) {
    const double k = __builtin_rint(x * 1.4426950408889634074); const double r = x - k * 0.693147180559945309417;
    double t = 1.0, s = 1.0;
    for (int i = 1; i <= 22; ++i) { t *= r / (double)i; s += t; }
    const long long bits = ((long long)(1023 + (int)k)) << 52; return s * __builtin_bit_cast(double, bits);
}
__device__ __forceinline__ void dsincos(double x, double& sn, double& cs) {
    const double k = __builtin_rint(x * 0.159154943091895335769); const double r = (x - k * 6.28318530717958623200) - k * 2.4492935982947064e-16;
    const double r2 = r * r; double ts = r, tc = 1.0; sn = r; cs = 1.0;
    for (int i = 1; i <= 16; ++i) { tc *= -r2 / (double)((2 * i - 1) * (2 * i)); cs += tc; ts *= -r2 / (double)((2 * i) * (2 * i + 1)); sn += ts; }
}
struct SsmMode { cplx ab, f; };
__device__ __forceinline__ SsmMode ssm_mode(const float* a_re, const float* a_im, const float* log_dt, int g, int n) {
    const double lr = (double)a_re[g * SN + n], li = (double)a_im[g * SN + n], dt = dexp((double)log_dt[g]);
    const double mag = dexp(lr * dt); double sn, cs; dsincos(li * dt, sn, cs);
    SsmMode mo; mo.ab = cplx{mag * cs, mag * sn};
    const double nr = mo.ab.re - 1.0, ni = mo.ab.im, den = lr * lr + li * li;
    mo.f = cplx{(nr * lr + ni * li) / den, (ni * lr - nr * li) / den};
    return mo;
}

constexpr int AKP = 144, AVP = 160, ASLOT = 128 * (AKP + AVP), ALDS_V = 128 * AKP;
typedef short v4i16_t __attribute__((ext_vector_type(4)));
__device__ __forceinline__ void attn_step_decode(int g, int& p, int& r, int& n) { p = g >> 4; const int q = g & 15; r = q >> (4 - 2 * p); n = q & ((16 >> (2 * p)) - 1); }
__device__ __forceinline__ void attn_load_kv(const bf16_t* QKV, int b, int h, int g, int tid, u32x4 (&kreg)[2], u32x4 (&vreg)[2]) {
    int p, r, n; attn_step_decode(g, p, r, n);
#pragma unroll
    for (int i = 0; i < 2; ++i) { const int cid = tid + 512 * i, row = cid >> 3, cc = cid & 7;
        const bf16_t* src = QKV + ((size_t)(b * 8 + h) * SEQ + ((n * 128 + row) << (2 * p)) + r) * 64 + cc * 8;
        kreg[i] = __builtin_nontemporal_load((const u32x4*)(src + (size_t)M * 512)); vreg[i] = __builtin_nontemporal_load((const u32x4*)(src + (size_t)2 * M * 512)); }
}
__device__ __forceinline__ void attn_load_q(const bf16_t* QKV, int b, int h, int g, int w, int fr, int fq, u32x4 (&qreg)[2]) {
    int p, r, n; attn_step_decode(g, p, r, n);
    const bf16_t* qs = QKV + ((size_t)(b * 8 + h) * SEQ + ((n * 128 + 16 * w + fr) << (2 * p)) + r) * 64 + fq * 8;
    qreg[0] = __builtin_nontemporal_load((const u32x4*)qs); qreg[1] = __builtin_nontemporal_load((const u32x4*)(qs + 32));
}
__device__ __forceinline__ void attn_store_kv(LAS unsigned char* lds, int slot, int tid, const u32x4 (&kreg)[2], const u32x4 (&vreg)[2]) {
#pragma unroll
    for (int i = 0; i < 2; ++i) { const int cid = tid + 512 * i, row = cid >> 3, cc = cid & 7;
        *(LAS u32x4*)(lds + slot * ASLOT + row * AKP + cc * 16) = kreg[i];
        *(LAS u32x4*)(lds + slot * ASLOT + ALDS_V + row * AVP + cc * 16) = vreg[i]; }
}
template <int DUMMY>
__device__ __forceinline__ void attn_step(const int g, LAS unsigned char* lds, const bf16_t* QKV, bf16_t* OY, float* LSE, const int b, const int h, const int w, const int tid, const int fr, const int fq,
                                          const float slope_base, u32x4 (&kreg)[2], u32x4 (&vreg)[2], u32x4 (&qreg)[2]) {
    constexpr int NSTEP = 48;
        asm volatile("s_waitcnt lgkmcnt(0)" ::: "memory"); __builtin_amdgcn_s_barrier(); asm volatile("" ::: "memory");
        if (g + 1 < NSTEP) attn_store_kv(lds, (g + 1) % 3, tid, kreg, vreg);
        int p, r, n; attn_step_decode(g, p, r, n);
        const size_t tok = (size_t)(b * SEQ + ((n * 128 + 16 * w + fr) << (2 * p)) + r);
        bf16_t* op = OY + tok * 768 + h * 64 + 8 * fq; float* lp = LSE + tok * 8 + h;
        u32x4 ro4[2]; float rl = 0.f;
        if (p > 0) { ro4[0] = __builtin_nontemporal_load((const u32x4*)op); ro4[1] = __builtin_nontemporal_load((const u32x4*)(op + 32)); rl = *lp; }
        if (g + 3 < NSTEP) attn_load_kv(QKV, b, h, g + 3, tid, kreg, vreg);
        const bf16x8 q0 = __builtin_bit_cast(bf16x8, qreg[0]), q1 = __builtin_bit_cast(bf16x8, qreg[1]);
        const int sc = g % 3, sp = (g + 2) % 3;
        const float slope2 = slope_base * (float)(1 << (2 * p));
        const int d0 = fr - 4 * fq; const float base = -slope2 * (float)(128 + d0);
        f32x4 sacc[9];
        __builtin_amdgcn_s_setprio(1);
#pragma unroll
        for (int jj = 0; jj < 9; ++jj) { const int jt = w + jj; const float bt = base + ((n > 0 || jt >= 8) ? 0.f : -1.0e30f);
            const LAS unsigned char* kp = lds + (jt >= 8 ? sc : sp) * ASLOT + (16 * (jt & 7) + fr) * AKP + fq * 16;
            const bf16x8 k0 = *(const LAS bf16x8*)kp, k1 = *(const LAS bf16x8*)(kp + 64);
            f32x4 z = (f32x4){bt + slope2 * (float)(16 * jj), bt + slope2 * (float)(16 * jj + 1), bt + slope2 * (float)(16 * jj + 2), bt + slope2 * (float)(16 * jj + 3)};
            z = __builtin_amdgcn_mfma_f32_16x16x32_bf16(k0, q0, z, 0, 0, 0);
            sacc[jj] = __builtin_amdgcn_mfma_f32_16x16x32_bf16(k1, q1, z, 0, 0, 0); }
        __builtin_amdgcn_s_setprio(0);
        if (g + 2 < NSTEP) attn_load_q(QKV, b, h, g + 2, w, fr, fq, qreg);
#pragma unroll
        for (int i = 0; i < 4; ++i) { sacc[0][i] = (i >= d0) ? sacc[0][i] : -1.0e30f; sacc[8][i] = (i <= d0) ? sacc[8][i] : -1.0e30f; }
        float mx = -3.0e38f;
#pragma unroll
        for (int jj = 0; jj < 9; ++jj)
#pragma unroll
            for (int i = 0; i < 4; ++i) mx = fmaxf(mx, sacc[jj][i]);
        mx = fmaxf(mx, __shfl_xor(mx, 16)); mx = fmaxf(mx, __shfl_xor(mx, 32));
        float lsum = 0.f; u32x2 pk[9];
#pragma unroll
        for (int jj = 0; jj < 9; ++jj) { float pp[4];
#pragma unroll
            for (int i = 0; i < 4; ++i) { pp[i] = __builtin_amdgcn_exp2f(sacc[jj][i] - mx); lsum += pp[i]; }
            pk[jj].x = cvt_pk_bf16(pp[0], pp[1]); pk[jj].y = cvt_pk_bf16(pp[2], pp[3]); }
        lsum += __shfl_xor(lsum, 16); lsum += __shfl_xor(lsum, 32);
        f32x4 oacc[4];
#pragma unroll
        for (int et = 0; et < 4; ++et) oacc[et] = (f32x4){0.f, 0.f, 0.f, 0.f};
        __builtin_amdgcn_s_setprio(1);
#pragma unroll
        for (int c = 0; c < 5; ++c) { const int ja = w + 2 * c, jb = (c < 4) ? ja + 1 : ja;
            {
                u32x4 pb; pb.x = pk[2 * c].x; pb.y = pk[2 * c].y; pb.z = (c < 4) ? pk[(c < 4) ? 2 * c + 1 : 0].x : 0u; pb.w = (c < 4) ? pk[(c < 4) ? 2 * c + 1 : 0].y : 0u;
                const bf16x8 pfrag = __builtin_bit_cast(bf16x8, pb);
                const LAS unsigned char* va_p = lds + (ja >= 8 ? sc : sp) * ASLOT + ALDS_V + (16 * (ja & 7) + 4 * fq + (fr >> 2)) * AVP + 16 * (fr & 3);
                const LAS unsigned char* vb_p = lds + (jb >= 8 ? sc : sp) * ASLOT + ALDS_V + (16 * (jb & 7) + 4 * fq + (fr >> 2)) * AVP + 16 * (fr & 3);
#pragma unroll
                for (int et = 0; et < 4; ++et) {
                    const u32x2 va = __builtin_bit_cast(u32x2, __builtin_amdgcn_ds_read_tr16_b64_v4i16((LAS v4i16_t*)(va_p + 64 * (et >> 1) + 8 * (et & 1))));
                    const u32x2 vb = __builtin_bit_cast(u32x2, __builtin_amdgcn_ds_read_tr16_b64_v4i16((LAS v4i16_t*)(vb_p + 64 * (et >> 1) + 8 * (et & 1))));
                    u32x4 vf; vf.x = va.x; vf.y = va.y; vf.z = vb.x; vf.w = vb.y;
                    oacc[et] = __builtin_amdgcn_mfma_f32_16x16x32_bf16(__builtin_bit_cast(bf16x8, vf), pfrag, oacc[et], 0, 0, 0); } } }
        __builtin_amdgcn_s_setprio(0);
        const float lse_n = mx + __builtin_amdgcn_logf(lsum); float ca = 0.f, cb = 1.f / lsum, lse_o = lse_n;
        if (p > 0) { const float mm = fmaxf(rl, lse_n), wr_ = __builtin_amdgcn_exp2f(rl - mm), wn_ = __builtin_amdgcn_exp2f(lse_n - mm), den = wr_ + wn_, rd = 1.f / den;
            ca = wr_ * rd; cb = wn_ * rd * cb; lse_o = mm + __builtin_amdgcn_logf(den); }
#pragma unroll
        for (int hf = 0; hf < 2; ++hf) { float o[8];
#pragma unroll
            for (int j = 0; j < 8; ++j) o[j] = oacc[2 * hf + (j >> 2)][j & 3] * cb;
            if (p > 0) { float rr[8]; unpack8(ro4[hf], rr);
#pragma unroll
                for (int j = 0; j < 8; ++j) o[j] += ca * rr[j]; }
            *(u32x4*)(op + 32 * hf) = pack8(o); }
        if (fq == 0 && p < 2) *lp = lse_o;
}

__device__ __forceinline__ void attn_phase(LAS unsigned char* lds, const bf16_t* QKV, bf16_t* OY, float* LSE, int bh, const int w, const int lane) {
    const int tid = w * 64 + lane, fr = lane & 15, fq = lane >> 4, b = bh >> 3, h = bh & 7;
    constexpr int NSTEP = 48;
    u32x4 kA[2], vA[2], kB[2], vB[2], qE[2], qO[2];
    for (int i = tid; i < ASLOT / 16; i += NTHR) *(LAS u32x4*)(lds + 2 * ASLOT + i * 16) = (u32x4){0u, 0u, 0u, 0u};
    attn_load_kv(QKV, b, h, 0, tid, kB, vB);
    attn_load_q(QKV, b, h, 0, w, fr, fq, qE);
    attn_store_kv(lds, 0, tid, kB, vB);
    attn_load_kv(QKV, b, h, 1, tid, kA, vA);
    attn_load_q(QKV, b, h, 1, w, fr, fq, qO);
    attn_load_kv(QKV, b, h, 2, tid, kB, vB);
    const float slope_base = __builtin_amdgcn_exp2f(-(float)(h + 1)) * LOG2E;
#pragma unroll 1
    for (int g = 0; g < NSTEP; g += 2) {
        attn_step<0>(g, lds, QKV, OY, LSE, b, h, w, tid, fr, fq, slope_base, kA, vA, qE);
        attn_step<1>(g + 1, lds, QKV, OY, LSE, b, h, w, tid, fr, fq, slope_base, kB, vB, qO);
    }
    __syncthreads();
}

__device__ __forceinline__ int lds_grab(LAS int* ctr, int lane) { int c = 0; if (lane == 0) c = __hip_atomic_fetch_add((int*)ctr, 1, __ATOMIC_RELAXED, __HIP_MEMORY_SCOPE_WORKGROUP); return __builtin_amdgcn_readfirstlane(c); }
__device__ __forceinline__ void modnorm_rows(const float* X, const float* gw, const float* MOD, int sh_off, int sc_off, bf16_t* XN, int row_base, int nrows, LAS int* ctr, int lane) {
    const int b = row_base >> 11, nchunk = nrows >> 2;
    f32x4 gm[4], shv[4];
    { const float* mp = MOD + b * 6144 + 4 * lane;
#pragma unroll
      for (int j = 0; j < 4; ++j) { const f32x4 g4 = *(const f32x4*)(gw + 4 * lane + 256 * j), sc = *(const f32x4*)(mp + sc_off + 256 * j); shv[j] = *(const f32x4*)(mp + sh_off + 256 * j);
          gm[j] = (f32x4){g4[0] * (1.f + sc[0]), g4[1] * (1.f + sc[1]), g4[2] * (1.f + sc[2]), g4[3] * (1.f + sc[3])}; } }
    int ch = lds_grab(ctr, lane);
    if (ch >= nchunk) return;
    f32x4 v[4][4], nv[4][4];
#pragma unroll
    for (int q = 0; q < 4; ++q) { const f32x4* xr = (const f32x4*)(X + (size_t)(row_base + 4 * ch + q) * DM) + lane;
#pragma unroll
        for (int j = 0; j < 4; ++j) v[q][j] = __builtin_nontemporal_load(xr + 64 * j); }
    for (;;) {
        const int nch = lds_grab(ctr, lane); const bool more = nch < nchunk; const int pch = more ? nch : ch;
#pragma unroll
        for (int q = 0; q < 4; ++q) { const f32x4* xr = (const f32x4*)(X + (size_t)(row_base + 4 * pch + q) * DM) + lane;
#pragma unroll
            for (int j = 0; j < 4; ++j) nv[q][j] = __builtin_nontemporal_load(xr + 64 * j); }
#pragma unroll
        for (int q = 0; q < 4; ++q) { const int row = row_base + 4 * ch + q; float s = 0.f;
#pragma unroll
            for (int j = 0; j < 4; ++j) s += (v[q][j][0] * v[q][j][0] + v[q][j][1] * v[q][j][1]) + (v[q][j][2] * v[q][j][2] + v[q][j][3] * v[q][j][3]);
            const float rstd = 1.f / sqrtf(wave_sum(s) * (1.f / DM) + EPS);
#pragma unroll
            for (int j = 0; j < 4; ++j) { float o[4];
#pragma unroll
                for (int e = 0; e < 4; ++e) o[e] = (v[q][j][e] * rstd) * gm[j][e] + shv[j][e];
                u32x2 pkd; pkd.x = cvt_pk_bf16(o[0], o[1]); pkd.y = cvt_pk_bf16(o[2], o[3]);
                *(u32x2*)(XN + (size_t)row * DM + 4 * lane + 256 * j) = pkd; } }
        if (!more) break;
        ch = nch;
#pragma unroll
        for (int q = 0; q < 4; ++q)
#pragma unroll
            for (int j = 0; j < 4; ++j) v[q][j] = nv[q][j];
    }
}

constexpr int TI_IN = (DM / 64) * (INW / 32), TI_PA = (AW / 64) * (DM / 32), TI_PS = (SW / 64) * (DM / 32), TI_GLU = (SW / 64) * (SW / 32), TI_OUT = (DM / 64) * (DM / 32),
              TI_UP = (DM / 64) * (2 * FF / 32), TI_DN = (FF / 64) * (DM / 32), NIT = TI_IN + TI_PA + TI_PS + TI_GLU + TI_OUT + TI_UP + TI_DN, NIT0 = 2048;
typedef const __attribute__((address_space(4))) Args* KArgs;
__device__ __forceinline__ void transpose_any(KArgs ka, int it, LAS float* scr, int lane) {
    unsigned char* wsb = ka->ws; int r = it;
    if (r < TI_IN) { transpose_item(ka->in[5], DM, INW, (bf16_t*)(wsb + WS_WIN), scr, r, lane); return; } r -= TI_IN;
    if (r < TI_PA) { transpose_item(ka->in[17], AW, DM, (bf16_t*)(wsb + WS_WPA), scr, r, lane, false, AW + SW, 0); return; } r -= TI_PA;
    if (r < TI_PS) { transpose_item(ka->in[18], SW, DM, (bf16_t*)(wsb + WS_WPA), scr, r, lane, false, AW + SW, AW); return; } r -= TI_PS;
    if (r < TI_GLU) { transpose_item(ka->in[15], SW, SW, (bf16_t*)(wsb + WS_WGLU), scr, r, lane); return; } r -= TI_GLU;
    if (r < TI_OUT) { transpose_item(ka->in[19], DM, DM, (bf16_t*)(wsb + WS_WOUT), scr, r, lane); return; } r -= TI_OUT;
    if (r < TI_UP) { transpose_item(ka->in[21], DM, 2 * FF, (bf16_t*)(wsb + WS_WUP), scr, r, lane, true); return; } r -= TI_UP;
    transpose_item(ka->in[24], FF, DM, (bf16_t*)(wsb + WS_WDN), scr, r, lane);
}

#define XB_TMO      128
#define XB_XCNT(j)  (256  + 64 * (j))
#define XB_XSUB(j)  (1280 + 64 * (j))
#define XB_XGEN(j)  (2304 + 64 * (j))
#define XB_TOP      3328
#define XB_TOPGEN   3392
#define XCD_BAR_WORDS 3456
#define XB_SPIN_CAP (1u << 22)
__device__ __forceinline__ unsigned xb_ld(unsigned* p)              { return __hip_atomic_load(p, __ATOMIC_RELAXED, __HIP_MEMORY_SCOPE_AGENT); }
__device__ __forceinline__ unsigned xb_add(unsigned* p, unsigned v) { return __hip_atomic_fetch_add(p, v, __ATOMIC_RELAXED, __HIP_MEMORY_SCOPE_AGENT); }
__device__ __forceinline__ unsigned xb_xcc_id() { return (unsigned)__builtin_amdgcn_s_getreg((3 << 11) | 20) & 0xFu; }
#define XB_SPIN(cond, bar) do { unsigned _sp = 0; while (cond) { __builtin_amdgcn_s_sleep(1); \
    if ((++_sp & 255u) == 0u) { if (xb_ld(&(bar)[XB_TMO])) break; if (_sp > XB_SPIN_CAP) { atomicAdd(&(bar)[XB_TMO], 1u); break; } } } } while (0)
__device__ __forceinline__ void xcd_barrier_complete(unsigned* bar, unsigned x, unsigned G, unsigned& nloc, unsigned& nx) {
    unsigned sum, cnt, mine, sp = 0u;
    for (;;) {
        sum = 0u; cnt = 0u; mine = 0u;
#pragma unroll
        for (unsigned j = 0; j < 16; ++j) { const unsigned c = xb_ld(&bar[XB_XCNT(j)]); sum += c; cnt += (c > 0u) ? 1u : 0u; mine = (j == x) ? c : mine; }
        if (sum == G) break;
        __builtin_amdgcn_s_sleep(1);
        if ((++sp & 255u) == 0u) { if (xb_ld(&bar[XB_TMO])) break; if (sp > XB_SPIN_CAP) { atomicAdd(&bar[XB_TMO], 1u); break; } }
    }
    nloc = mine > 0u ? mine : 1u; nx = cnt > 0u ? cnt : 1u;
}
__device__ __forceinline__ void grid_barrier(unsigned* bar, unsigned x, volatile LAS unsigned* st, unsigned G, int wave) {
    asm volatile("s_waitcnt vmcnt(0)" ::: "memory");
    __syncthreads();
    if (wave == 0) {
        int z_; asm volatile("s_mov_b32 %0, 0" : "=s"(z_));
        if ((int)__builtin_amdgcn_mbcnt_hi(~0u, __builtin_amdgcn_mbcnt_lo(~0u, (unsigned)z_)) == 0) {
            __builtin_amdgcn_s_waitcnt(0);
            unsigned nloc = st[0], nx = st[1];
            if (nloc == 0u) { xcd_barrier_complete(bar, x, G, nloc, nx); st[0] = nloc; st[1] = nx; }
            const unsigned old = xb_add(&bar[XB_XSUB(x)], 1u);
            const unsigned gen = old / nloc;
            if (old + 1u == (gen + 1u) * nloc) {
                __builtin_amdgcn_fence(__ATOMIC_RELEASE, "agent");
                asm volatile("s_waitcnt vmcnt(0)" ::: "memory");
                const unsigned og = xb_add(&bar[XB_TOP], 1u);
                const unsigned tg = og / nx;
                if (og + 1u == (tg + 1u) * nx) xb_add(&bar[XB_TOPGEN], 1u);
                else XB_SPIN(xb_ld(&bar[XB_TOPGEN]) == tg, bar);
                __builtin_amdgcn_fence(__ATOMIC_ACQUIRE, "agent");
                xb_add(&bar[XB_XGEN(x)], 1u);
                asm volatile("s_waitcnt vmcnt(0)" ::: "memory");
            } else {
                XB_SPIN(xb_ld(&bar[XB_XGEN(x)]) == gen, bar);
                __builtin_amdgcn_fence(__ATOMIC_ACQUIRE, "agent");
                asm volatile("s_waitcnt vmcnt(0)" ::: "memory");
            }
        }
    }
    __syncthreads();
}

__global__ void __launch_bounds__(NTHR, 2) fwd(Args a) {
    __builtin_assume(__builtin_amdgcn_workitem_id_y() == 0); __builtin_assume(__builtin_amdgcn_workitem_id_z() == 0);
    extern __shared__ __attribute__((aligned(16))) unsigned char lds_raw[];
    LAS unsigned char* lds = (LAS unsigned char*)lds_raw;
    const int wave = __builtin_amdgcn_readfirstlane((int)threadIdx.x >> 6);
    const int G = gridDim.x, bx = blockIdx.x;
    const int vcu = (G % 8 == 0) ? (bx % 8) * (G / 8) + bx / 8 : bx;
    const int gwave = vcu * NWAVES + wave, ngw = G * NWAVES;
    const int ngt = G * NTHR;
    const KArgs ka = (KArgs)__builtin_amdgcn_kernarg_segment_ptr();
#define ws (ka->ws)
#define x (ka->in[0])
#define cvec (ka->in[1])
#define w_ada (ka->in[2])
#define b_ada (ka->in[3])
#define g_mix (ka->in[4])
#define w_in (ka->in[5])
#define b_gate (ka->in[6])
#define a_re (ka->in[7])
#define a_im (ka->in[8])
#define log_dt (ka->in[9])
#define b_re (ka->in[10])
#define b_im (ka->in[11])
#define c_re (ka->in[12])
#define c_im (ka->in[13])
#define d_skip (ka->in[14])
#define w_glu (ka->in[15])
#define b_glu (ka->in[16])
#define w_pa (ka->in[17])
#define w_ps (ka->in[18])
#define w_out (ka->in[19])
#define g_ffn (ka->in[20])
#define w_up (ka->in[21])
#define w_conv (ka->in[22])
#define b_conv (ka->in[23])
#define w_down (ka->in[24])
#define g_final (ka->in[25])
#define out (ka->out)
#define MOD ((float*)(ws + WS_MOD))
#define KS ((float*)(ws + WS_KS))
#define ATC ((float*)(ws + WS_ATC))
#define MODE ((double*)(ws + WS_MODE))
#define PW ((double*)(ws + WS_PW))
#define WIN ((bf16_t*)(ws + WS_WIN))
#define WPA ((bf16_t*)(ws + WS_WPA))
#define WPS ((bf16_t*)(ws + WS_WPS))
#define WGLU ((bf16_t*)(ws + WS_WGLU))
#define WOUT ((bf16_t*)(ws + WS_WOUT))
#define WUP ((bf16_t*)(ws + WS_WUP))
#define WDN ((bf16_t*)(ws + WS_WDN))
#define WST ((bf16_t*)(ws + WS_WST))
#define KW ((bf16_t*)(ws + WS_KW))
#define SLOC4 ((float*)(ws + WS_SLOC4))
#define LSE ((float*)(ws + WS_LSE))
#define XN ((bf16_t*)(ws + WS_XN))
#define QKV ((bf16_t*)(ws + WS_QKV))
#define OATT ((bf16_t*)(ws + WS_OATT))
#define Y2 ((bf16_t*)(ws + WS_Y2))
#define YG ((bf16_t*)(ws + WS_YG))
#define GATES ((bf16_t*)(ws + WS_GATES))
#define UX ((bf16_t*)(ws + WS_UX))
#define OP ((bf16_t*)(ws + WS_OP))
#define UP ((bf16_t*)(ws + WS_UP))
#define HB ((bf16_t*)(ws + WS_HB))
#define HBF ((bf16_t*)(ws + WS_HBF))
#define SSQ ((float*)(ws + WS_SSQ))
#define SHW ((float*)(ws + WS_SHW))
    const int lo = ka->ph_lo, hi = ka->ph_hi;
#ifndef PHMASK
#define PHMASK 0xffff
#endif
#define IN(k) (((PHMASK >> (k)) & 1) && lo <= (k) && (k) < hi)
#define IDS() int z_; asm volatile("s_mov_b32 %0, 0" : "=s"(z_)); const int lane = (int)__builtin_amdgcn_mbcnt_hi(~0u, __builtin_amdgcn_mbcnt_lo(~0u, (unsigned)z_)); const int tid = wave * 64 + lane; const int gthr = vcu * NTHR + tid; (void)gthr; (void)tid
    if (lo < 0) cg::this_grid().sync();
    unsigned* const xbar = (unsigned*)(ws + 16384); const unsigned xcc = xb_xcc_id();
    volatile LAS unsigned* const xst = (volatile LAS unsigned*)(lds + 147456 - 64);
    if (__builtin_amdgcn_workitem_id_x() == 0) { xst[0] = 0u; xst[1] = 0u; (void)xb_add(&xbar[XB_XCNT(xcc)], 1u); }
    __syncthreads();
#define SEAM(k) do { if (IN(k) && IN((k) + 1)) grid_barrier(xbar, xcc, xst, (unsigned)G, wave); } while (0)

    if (IN(0)) { IDS();
        if (bx < 192) gemv32<true, false>(lds, cvec, DM, w_ada, 6 * DM, bx * 32, b_ada, MOD, 6 * DM, tid, wave, lane);
        else {
            if (tid < 16) { const int it = (bx - 192) * 16 + tid, g = it >> 6, n = it & 63;
                const SsmMode mo = ssm_mode(a_re, a_im, log_dt, g, n);
                double* md = MODE + (size_t)it * 4; md[0] = mo.ab.re; md[1] = mo.ab.im; md[2] = mo.f.re; md[3] = mo.f.im;
                double* pw = PW + (size_t)it * 130; cplx p{1.0, 0.0};
                for (int t = 0; t <= TCH; ++t) { pw[2 * t] = p.re; pw[2 * t + 1] = p.im; p = cmul(p, mo.ab); }
                ATC[it * 2] = (float)pw[2 * TCH]; ATC[it * 2 + 1] = (float)pw[2 * TCH + 1]; }
            LAS float* scr = (LAS float*)(lds + wave * 16384);
            for (int it = (bx - 192) * NWAVES + wave; it < NIT0; it += 64 * NWAVES) transpose_any(ka, it, scr, lane);
        }
    }
    SEAM(0);
    if (IN(1)) { IDS();
        { LAS float* scr = (LAS float*)(lds + wave * 16384);
          for (int it = NIT0 + gwave; it < NIT; it += ngw) transpose_any(ka, it, scr, lane); }
        LAS int* ctr = (LAS int*)(lds + 131072 + 8192);
        if (tid == 0) *ctr = 0;
        __syncthreads();
        if (wave == 7) { const int it = vcu * 64 + lane, g = it >> 10, tau = (it >> 4) & 63, c = it & 15;
            double kacc[16];
#pragma unroll
            for (int j = 0; j < 16; ++j) kacc[j] = 0.0;
            for (int n = 0; n < SN; ++n) { const double* md = MODE + (size_t)(g * SN + n) * 4; const double* pw = PW + (size_t)(g * SN + n) * 130 + 2 * tau;
                const cplx cc = cplx{(double)c_re[(g * SC + c) * SN + n], (double)c_im[(g * SC + c) * SN + n]}; const cplx ca = cmul(cmul(cc, cplx{pw[0], pw[1]}), cplx{md[2], md[3]});
#pragma unroll
                for (int j = 0; j < 16; ++j) { const double br = (double)b_re[(g * SN + n) * SC + j], bi = (double)b_im[(g * SN + n) * SC + j]; kacc[j] += ca.re * br - ca.im * bi; } }
#pragma unroll
            for (int j = 0; j < 16; ++j) KS[(size_t)it * 16 + j] = (float)kacc[j]; }
        if (wave >= 3 && wave < 7) { const int it = ((wave - 3) * G + vcu) * 64 + lane, g = it >> 12, n = (it >> 6) & 63, s = it & 63;
            const double* md = MODE + (size_t)(g * SN + n) * 4; const double* pwt = PW + (size_t)(g * SN + n) * 130; const cplx fm{md[2], md[3]};
            { const cplx pf = cmul(cplx{pwt[2 * (TCH - 1 - s)], pwt[2 * (TCH - 1 - s) + 1]}, fm); float wre[16], wim[16];
#pragma unroll
              for (int j = 0; j < 16; ++j) { const double br = (double)b_re[(g * SN + n) * SC + j], bi = (double)b_im[(g * SN + n) * SC + j]; wre[j] = (float)(pf.re * br - pf.im * bi); wim[j] = (float)(pf.re * bi + pf.im * br); }
              bf16_t* d0 = WST + (size_t)(g * 256 + n) * 1024 + s * 16; bf16_t* d1 = d0 + (size_t)64 * 1024;
              *(u32x4*)d0 = pack8(wre); *(u32x4*)(d0 + 8) = pack8(wre + 8); *(u32x4*)d1 = pack8(wim); *(u32x4*)(d1 + 8) = pack8(wim + 8);
              bf16_t* z0 = d0 + (size_t)128 * 1024; bf16_t* z1 = d1 + (size_t)128 * 1024; const u32x4 zz = (u32x4){0u, 0u, 0u, 0u};
              *(u32x4*)z0 = zz; *(u32x4*)(z0 + 8) = zz; *(u32x4*)z1 = zz; *(u32x4*)(z1 + 8) = zz; }
            { const int i = s; const cplx pw{pwt[2 * (i + 1)], pwt[2 * (i + 1) + 1]};
              for (int c = 0; c < SC; ++c) { const cplx cc = cplx{(double)c_re[(g * SC + c) * SN + n], (double)c_im[(g * SC + c) * SN + n]}; const cplx ca = cmul(cc, pw);
                  bf16_t* d = KW + (size_t)(g * 1024 + i * 16 + c) * KX + 1024 + n;
                  d[0] = (bf16_t)(cvt_pk_bf16((float)ca.re, 0.f) & 0xffffu); d[64] = (bf16_t)(cvt_pk_bf16((float)(-ca.im), 0.f) & 0xffffu); } }
        }
        modnorm_rows(x, g_mix, MOD, 0, 1024, XN, vcu * (M / G), M / G, ctr, lane);
    }
    SEAM(1);
    if (IN(2)) { IDS();
        pg8::Gemm g{XN, WIN, DM, DM, DM}; pg8::StaticOrder S; S.init(M, INW, G, bx);
        pg8::EpiInProj E{QKV, UX, GATES, b_gate};
        pg8::gemm_phase(lds, g, S, E, wave, lane);
    }
    SEAM(2);
    if (IN(3)) { IDS();
        { const int kq = bx & 3; pg8::Gemm g{UX + kq * 256, WST + kq * 256, KX, 1024, 256}; pg8::SchedS1 S{bx}; pg8::EpiS1 E{SLOC4 + (size_t)kq * (SG * 1024 * 128)}; pg8::gemm_phase(lds, g, S, E, wave, lane); }
        for (int it = gthr; it < SG * TCH * SC * TCH; it += ngt) { const int g = it >> 16, i = (it >> 10) & 63, c = (it >> 6) & 15, s = it & 63;
            u32x4 o0 = (u32x4){0u, 0u, 0u, 0u}, o1 = o0;
            if (s <= i) { const float* kp = KS + ((size_t)((g * 64 + (i - s)) * 16 + c)) * 16; float kv[16];
#pragma unroll
                for (int j = 0; j < 16; ++j) kv[j] = kp[j];
                o0 = pack8(kv); o1 = pack8(kv + 8); }
            bf16_t* d = KW + (size_t)(g * 1024 + i * 16 + c) * KX + s * 16; *(u32x4*)d = o0; *(u32x4*)(d + 8) = o1; }
        attn_phase(lds, QKV, OATT, LSE, bx, wave, lane);
    }
    SEAM(3);
    if (IN(5)) { IDS();
        {
            const int g = bx >> 4, pmm = (bx >> 2) & 3, bl = tid >> 6, n = tid & 63; constexpr size_t PS = (size_t)SG * 1024 * 128;
            const float ar = ATC[(g * SN + n) * 2], ai = ATC[(g * SN + n) * 2 + 1]; float xr = 0.f, xi = 0.f;
            for (int c8 = 0; c8 < NCH; c8 += 8) { float sr[8], si[8];
#pragma unroll
                for (int q = 0; q < 8; ++q) { const size_t rowi = (size_t)(g * 1024 + pmm * 256 + bl * NCH + c8 + q); const float* sp0 = SLOC4 + rowi * 128 + n;
                    sr[q] = (sp0[0] + sp0[PS]) + (sp0[2 * PS] + sp0[3 * PS]); si[q] = (sp0[64] + sp0[PS + 64]) + (sp0[2 * PS + 64] + sp0[3 * PS + 64]); }
#pragma unroll
                for (int q = 0; q < 8; ++q) { const size_t rowi = (size_t)(g * 1024 + pmm * 256 + bl * NCH + c8 + q);
                    bf16_t* d = UX + rowi * KX + 1024 + n; d[0] = (bf16_t)(cvt_pk_bf16(xr, 0.f) & 0xffffu); d[64] = (bf16_t)(cvt_pk_bf16(xi, 0.f) & 0xffffu);
                    const float nr = ar * xr - ai * xi + sr[q], ni = ar * xi + ai * xr + si[q]; xr = nr; xi = ni; } }
            asm volatile("s_waitcnt vmcnt(0)" ::: "memory"); __syncthreads();
        }
        pg8::Gemm g{UX, KW, KX, KX, KX}; pg8::SchedS3 S{G, bx}; pg8::EpiS3 E{UX, d_skip, Y2}; pg8::gemm_phase(lds, g, S, E, wave, lane); }
    SEAM(5);
    if (IN(6)) { IDS(); pg8::Gemm g{Y2, WGLU, SW, SW, SW}; pg8::StaticOrder S; S.init(M, SW, G, bx); pg8::EpiGlu E{Y2, b_glu, OATT}; pg8::gemm_phase(lds, g, S, E, wave, lane);
        if (bx < 128) gemv32<false, true>(lds, MOD + 3072, 6 * DM, w_up, 2 * FF, bx * 32, nullptr, SHW, 2 * FF, tid, wave, lane); }
    SEAM(6);
    if (IN(7)) { IDS();
        pg8::Gemm g{OATT, WPA, AW + SW, AW + SW, AW + SW}; pg8::StaticOrder S; S.init(M, DM, G, bx); pg8::EpiMerge1 E{GATES, XN};
        pg8::gemm_phase<pg8::EpiMerge1, pg8::StaticOrder, 8>(lds, g, S, E, wave, lane);
    }
    SEAM(7);
    if (IN(8)) { IDS(); pg8::Gemm g{XN, WOUT, DM, DM, DM}; pg8::StaticOrder S; S.init(M, DM, G, bx); pg8::EpiResNorm E{x, MOD, g_ffn, HBF, HB, SSQ}; pg8::gemm_phase(lds, g, S, E, wave, lane); }
    SEAM(8);
    if (IN(10)) { IDS(); pg8::Gemm g{HB, WUP, DM, DM, DM}; pg8::SchedChain S{bx}; pg8::EpiUpConv E{UP, w_conv, b_conv, (LAS float*)(lds + 131072), SSQ, SHW}; pg8::gemm_phase(lds, g, S, E, wave, lane); }
    SEAM(10);
    if (IN(12)) { IDS(); pg8::Gemm g{UP, WDN, FF, FF, FF}; pg8::StaticOrder S; S.init(M, DM, G, bx); pg8::EpiResFinal E{HBF, MOD + 5120, g_final, out, (float*)(ws + WS_XCH), (unsigned*)(ws + WS_CNT), (LAS float*)(lds + 131072 + 8192)}; pg8::gemm_phase(lds, g, S, E, wave, lane); }
#undef IN
#undef SEAM
}
#undef ws
#undef HBF
#undef SLOC4
#undef HB
#undef SSQ
#undef SHW
#undef MODE
#undef PW
#undef x
#undef cvec
#undef w_ada
#undef b_ada
#undef g_mix
#undef w_in
#undef b_gate
#undef a_re
#undef a_im
#undef log_dt
#undef b_re
#undef b_im
#undef c_re
#undef c_im
#undef d_skip
#undef w_glu
#undef b_glu
#undef w_pa
#undef w_ps
#undef w_out
#undef g_ffn
#undef w_up
#undef w_conv
#undef b_conv
#undef w_down
#undef g_final
#undef out
#undef MOD
#undef KS
#undef ATC
#undef WIN
#undef WPA
#undef WPS
#undef WGLU
#undef WOUT
#undef WUP
#undef WDN
#undef WST
#undef KW
#undef SLOC
#undef LSE
#undef XN
#undef QKV
#undef OATT
#undef Y2
#undef YG
#undef GATES
#undef UX
#undef OP
#undef UP

constexpr int N_PHASES = 14;
constexpr int LDS_BYTES = 147456;
extern "C" void kernel_launch(void* const* d_in, const int* in_sizes, int n_in, void* d_out, int out_size, void* d_ws, size_t ws_size, hipStream_t stream) {
    static int grid = 0;
    if (grid == 0) {
        if (n_in != 26 || in_sizes[0] != M * DM || out_size != M * DM || ws_size < WS_END) { fprintf(stderr, "kernel_launch: unexpected shapes (n_in %d in0 %d out %d ws %zu)\n", n_in, n_in > 0 ? in_sizes[0] : -1, out_size, ws_size); grid = -1; return; }
        int dev = 0, cus = 0, per_cu = 0;
        (void)hipGetDevice(&dev); (void)hipDeviceGetAttribute(&cus, hipDeviceAttributeMultiprocessorCount, dev);
        if (hipFuncSetAttribute((const void*)fwd, hipFuncAttributeMaxDynamicSharedMemorySize, LDS_BYTES) != hipSuccess) { fprintf(stderr, "kernel_launch: hipFuncSetAttribute failed\n"); grid = -1; return; }
        if (hipOccupancyMaxActiveBlocksPerMultiprocessor(&per_cu, (const void*)fwd, NTHR, LDS_BYTES) != hipSuccess || per_cu < 1) { fprintf(stderr, "kernel_launch: occupancy query says %d\n", per_cu); per_cu = 1; }
        (void)hipGetLastError();
        grid = cus * 1;
        if (grid != 256) { fprintf(stderr, "kernel_launch: built for a 256-CU device (got %d)\n", cus); grid = -1; return; }
        fprintf(stderr, "kernel_launch: grid %d (cus %d, per_cu %d)\n", grid, cus, per_cu);
    }
    if (grid < 0) return;
    (void)hipMemsetAsync(d_ws, 0, 32768, stream);
    Args a{};
    for (int i = 0; i < 26; ++i) a.in[i] = (const float*)d_in[i];
    a.out = (float*)d_out; a.ws = (unsigned char*)d_ws;
#if MK_SINGLE
    a.ph_lo = 0; a.ph_hi = N_PHASES;
    { void* args[] = {&a}; hipError_t e = hipLaunchCooperativeKernel((const void*)fwd, dim3(grid), dim3(NTHR), args, LDS_BYTES, stream);
      if (e != hipSuccess) fprintf(stderr, "cooperative launch failed: %s\n", hipGetErrorString(e)); }
#else
    for (int ph = 0; ph < N_PHASES; ++ph) for (int rep = 0; rep < (((PROBE_MASK >> ph) & 1) ? 1 + PROBE_REPS : 1); ++rep) { a.ph_lo = ph; a.ph_hi = ph + 1; void* args[] = {&a};
        hipError_t e = hipLaunchCooperativeKernel((const void*)fwd, dim3(grid), dim3(NTHR), args, LDS_BYTES, stream);
        if (e != hipSuccess) { fprintf(stderr, "cooperative launch %d failed: %s\n", ph, hipGetErrorString(e)); break; } }
#endif
}
```

```cpp
#include <hip/hip_runtime.h>
#include <hip/hip_cooperative_groups.h>
#include <cstdio>
#include <cstdint>
namespace cg = cooperative_groups;

#ifndef MK_SINGLE
#define MK_SINGLE 1
#endif

#ifndef PROBE_MASK
#define PROBE_MASK 0x000
#endif
#ifndef PROBE_REPS
#define PROBE_REPS 1
#endif
#define LAS __attribute__((address_space(3)))
#define GAS __attribute__((address_space(1)))
typedef unsigned short bf16_t;
typedef short bf16x8 __attribute__((ext_vector_type(8)));
typedef float f32x4 __attribute__((ext_vector_type(4)));
typedef unsigned u32x4 __attribute__((ext_vector_type(4)));
typedef unsigned u32x2 __attribute__((ext_vector_type(2)));

constexpr int DM = 1024, NBATCH = 32, SEQ = 2048, M = NBATCH * SEQ, NH = 8, HD = 64, AW = 512, SW = 256;
constexpr int SG = 16, SC = 16, SN = 64, FF = 2048, INW = 3840, TCH = 64  , NCH = SEQ / TCH  ;
constexpr int KX = TCH * SC + 2 * SN;
constexpr float LOG2E = 1.4426950408889634f;
constexpr float QSCALE = 0.125f * LOG2E;
constexpr float EPS = 1e-6f;
constexpr int NWAVES = 8, NTHR = 512;

constexpr size_t MiB = 1u << 20;
constexpr size_t WS_MOD = 1 * MiB;
constexpr size_t WS_KS = 2 * MiB;
constexpr size_t WS_ATC = 3 * MiB;
constexpr size_t WS_WIN = 4 * MiB;
constexpr size_t WS_WPA = 12 * MiB;
constexpr size_t WS_WPS = 13 * MiB;
constexpr size_t WS_WGLU = 13 * MiB + 512 * 1024;
constexpr size_t WS_WOUT = 14 * MiB;
constexpr size_t WS_WUP = 16 * MiB;
constexpr size_t WS_WDN = 24 * MiB;
constexpr size_t WS_WST = 28 * MiB;
constexpr size_t WS_KW = 36 * MiB;
constexpr size_t WS_SLOC = 72 * MiB;
constexpr size_t WS_LSE = 80 * MiB;
constexpr size_t WS_MODE = 3 * MiB + 65536;
constexpr size_t WS_PW = 88 * MiB;
constexpr size_t WS_SLOC4 = 96 * MiB;
constexpr size_t WS_XN = 96 * MiB;
constexpr size_t WS_QKV = 708 * MiB;
constexpr size_t WS_OATT = 224 * MiB;
constexpr size_t WS_Y2 = 320 * MiB;
constexpr size_t WS_YG = 320 * MiB;
constexpr size_t WS_GATES = 416 * MiB;
constexpr size_t WS_UX = 672 * MiB;
constexpr size_t WS_OP = 708 * MiB;
constexpr size_t WS_HB = 544 * MiB;
constexpr size_t WS_SSQ = 72 * MiB;
constexpr size_t WS_SHW = 90 * MiB;
constexpr size_t WS_HBF = 708 * MiB;
constexpr size_t WS_XCH = 91 * MiB;
constexpr size_t WS_CNT = 4096;
constexpr size_t WS_UP = 224 * MiB;
constexpr size_t WS_END = 900 * MiB;

__device__ __forceinline__ unsigned cvt_pk_bf16(float lo, float hi) { unsigned r; asm volatile("v_cvt_pk_bf16_f32 %0, %1, %2" : "=v"(r) : "v"(lo), "v"(hi)); return r; }
__device__ __forceinline__ float bf_lo(unsigned w) { return __builtin_bit_cast(float, w << 16); }
__device__ __forceinline__ float bf_hi(unsigned w) { return __builtin_bit_cast(float, w & 0xffff0000u); }
__device__ __forceinline__ float sigmoidf_(float x) { return __builtin_amdgcn_rcpf(1.f + __builtin_amdgcn_exp2f(-x * LOG2E)); }
__device__ __forceinline__ u32x4 pack8(const float* v) { u32x4 w; w.x = cvt_pk_bf16(v[0], v[1]); w.y = cvt_pk_bf16(v[2], v[3]); w.z = cvt_pk_bf16(v[4], v[5]); w.w = cvt_pk_bf16(v[6], v[7]); return w; }
__device__ __forceinline__ void unpack8(u32x4 w, float* v) { v[0] = bf_lo(w.x); v[1] = bf_hi(w.x); v[2] = bf_lo(w.y); v[3] = bf_hi(w.y); v[4] = bf_lo(w.z); v[5] = bf_hi(w.z); v[6] = bf_lo(w.w); v[7] = bf_hi(w.w); }
__device__ __forceinline__ float wave_sum(float v) {
#pragma unroll
    for (int o = 1; o < 64; o <<= 1) v += __shfl_xor(v, o);
    return v;
}

namespace pg8 {
constexpr int BM = 256, BK = 64, HALF = 128, HTB = HALF * BK * 2, STAGE_BYTES = 8 * HTB, NXCD = 8, WGM = 8;
__host__ __device__ __forceinline__ int lds_byte(int r, int c) { const int st = (r >> 4) * 2 + (c >> 5), rr = r & 15, cc = c & 31, ob = rr * 64 + cc * 2; return st * 1024 + (ob ^ (((ob >> 9) & 1) << 5)); }
__host__ __device__ __forceinline__ void stage_rc(int b, int& R, int& C) { const int st = b / 1024, sb = b % 1024, swz = sb ^ (((sb >> 9) & 1) << 5); R = (st >> 1) * 16 + swz / 64; C = (st & 1) * 32 + (swz % 64) / 2; }
__host__ __device__ __forceinline__ int perm32(int rho) { const int n = rho >> 4, i = rho & 15; return 8 * (i >> 2) + 4 * n + (i & 3); }

struct Unit { int pm, pn; };
struct Gemm { const bf16_t* A; const bf16_t* Bt; int lda, ldb, K; };

struct StaticOrder {
    int nM, nN, nwg, G, c;
    __device__ void init(int M_, int N_, int G_, int c_) { nM = M_ / BM; nN = N_ / BM; nwg = nM * nN; G = G_; c = c_; }
    __device__ bool next(int i, Unit& u) const {
        const long L = (long)i * G + c; if (L >= nwg) return false;
        int wgid = (int)L; { const int q = nwg / NXCD, r = nwg % NXCD, xcd = wgid % NXCD, off = wgid / NXCD; wgid = (xcd < r ? xcd * (q + 1) : r * (q + 1) + (xcd - r) * q) + off; }
        const int nig = WGM * nN, gid = wgid / nig, fm = gid * WGM, gsz = (nM - fm) < WGM ? (nM - fm) : WGM;
        u.pm = fm + ((wgid % nig) % gsz); u.pn = (wgid % nig) / gsz; return true;
    }
};
struct SchedS1 { int c; __device__ bool next(int i, Unit& u) const { if (i > 0) return false; const int L = c >> 2; u.pm = L; u.pn = L >> 2; return true; } };
struct SchedS3 { int G, c; __device__ bool next(int i, Unit& u) const { const int L = i * G + c; if (L >= 256) return false; const int g = L >> 4; u.pm = g * 4 + ((L >> 2) & 3); u.pn = g * 4 + (L & 3); return true; } };

#define EPI_BEGIN \
    _Pragma("unroll") for (int ai = 0; ai < 2; ++ai) _Pragma("unroll") for (int m = 0; m < 4; ++m) { const int row = u.pm * 256 + ai * 128 + wr * 64 + m * 16 + fr; \
    _Pragma("unroll") for (int bj = 0; bj < 2; ++bj) { const int col = u.pn * 256 + bj * 128 + wc * 32 + 8 * fq; \
        float v[8]; { const f32x4 v0 = acc[ai][bj][m][0], v1 = acc[ai][bj][m][1]; v[0] = v0[0]; v[1] = v0[1]; v[2] = v0[2]; v[3] = v0[3]; v[4] = v1[0]; v[5] = v1[1]; v[6] = v1[2]; v[7] = v1[3]; }
#define EPI_END } }
#define EPI_ARGS const f32x4 (&acc)[2][2][4][2], const Unit& u, int wr, int wc, int fr, int fq

struct EpiInProj {
    bf16_t* QKV; bf16_t* UX; bf16_t* GATES; const float* b_gate;
    __device__ __forceinline__ void operator()(EPI_ARGS) const {
        const int pn = u.pn;
        if (pn < 6) { const float sc = pn < 2 ? QSCALE : 1.f;
            EPI_BEGIN
#pragma unroll
                for (int j = 0; j < 8; ++j) v[j] *= sc;
                { const int which = col >> 9, hh = (col >> 6) & 7, e0 = col & 63;
                  *(u32x4*)(QKV + (size_t)which * ((size_t)M * 512) + ((size_t)((row >> 11) * 8 + hh) * SEQ + (row & 2047)) * 64 + e0) = pack8(v); }
            EPI_END
        } else if (pn == 6) {
            EPI_BEGIN
                const int lc = col - 1536, g = lc >> 4, c8 = lc & 15, b = row >> 11, t = row & 2047;
                *(u32x4*)(UX + (size_t)(g * 1024 + b * NCH + (t >> 6)) * KX + (t & 63) * 16 + c8) = pack8(v);
            EPI_END
        } else {
            EPI_BEGIN
                const int gc = col - 1792; const f32x4 b0 = *(const f32x4*)(b_gate + gc), b1 = *(const f32x4*)(b_gate + gc + 4);
                v[0] = sigmoidf_(v[0] + b0[0]); v[1] = sigmoidf_(v[1] + b0[1]); v[2] = sigmoidf_(v[2] + b0[2]); v[3] = sigmoidf_(v[3] + b0[3]);
                v[4] = sigmoidf_(v[4] + b1[0]); v[5] = sigmoidf_(v[5] + b1[1]); v[6] = sigmoidf_(v[6] + b1[2]); v[7] = sigmoidf_(v[7] + b1[3]);
                *(u32x4*)(GATES + (size_t)row * 2048 + gc) = pack8(v);
            EPI_END
        }
    }
};
struct EpiS1 {
    float* SLOC;
    __device__ __forceinline__ void operator()(EPI_ARGS) const {
        EPI_BEGIN
            if (bj == 0) { const int lc = col & 255; float* d = SLOC + (size_t)row * 128 + lc; *(f32x4*)d = (f32x4){v[0], v[1], v[2], v[3]}; *(f32x4*)(d + 4) = (f32x4){v[4], v[5], v[6], v[7]}; }
        EPI_END
    }
};
struct EpiS3 {
    const bf16_t* UX; const float* d_skip; bf16_t* Y2;
    __device__ __forceinline__ void operator()(EPI_ARGS) const {
        EPI_BEGIN
            const int g = row >> 10, bc = row & 1023, lc = col & 1023, i = lc >> 4, c8 = lc & 15;
            float uu[8]; unpack8(*(const u32x4*)(UX + (size_t)row * KX + lc), uu);
            const f32x4 d0 = *(const f32x4*)(d_skip + g * 16 + c8), d1 = *(const f32x4*)(d_skip + g * 16 + c8 + 4);
            const float dd[8] = {d0[0], d0[1], d0[2], d0[3], d1[0], d1[1], d1[2], d1[3]};
#pragma unroll
            for (int j = 0; j < 8; ++j) { const float y = v[j] + dd[j] * uu[j]; v[j] = y * sigmoidf_(1.5957691216057308f * (y + 0.044715f * y * y * y)); }
            *(u32x4*)(Y2 + (size_t)(bc * 64 + i) * 256 + g * 16 + c8) = pack8(v);
        EPI_END
    }
};
struct EpiGlu {
    const bf16_t* Y2; const float* b_glu; bf16_t* YG;
    __device__ __forceinline__ void operator()(EPI_ARGS) const {
        EPI_BEGIN
            float y[8]; unpack8(*(const u32x4*)(Y2 + (size_t)row * 256 + col), y);
            const f32x4 b0 = *(const f32x4*)(b_glu + col), b1 = *(const f32x4*)(b_glu + col + 4);
            const float bb[8] = {b0[0], b0[1], b0[2], b0[3], b1[0], b1[1], b1[2], b1[3]};
#pragma unroll
            for (int j = 0; j < 8; ++j) v[j] = y[j] * sigmoidf_(v[j] + bb[j]);
            *(u32x4*)(YG + (size_t)row * 768 + 512 + col) = pack8(v);
        EPI_END
    }
};
struct EpiMerge1 {
    const bf16_t* GATES; bf16_t* MG;
    __device__ __forceinline__ void mid(f32x4 (&acc)[2][2][4][2], const Unit& u, int wr, int wc, int fr, int fq) const {
        int pm_ = u.pm; asm volatile("" : "+s"(pm_));
        const bf16_t* gbase = GATES + (size_t)(pm_ * 256 + wr * 64 + fr) * 2048 + u.pn * 256 + wc * 32 + 8 * fq;
#pragma unroll
        for (int ai = 0; ai < 2; ++ai)
#pragma unroll
            for (int m = 0; m < 4; ++m) {
#pragma unroll
                for (int bj = 0; bj < 2; ++bj) { const bf16_t* gp = gbase + (size_t)(ai * 128 + m * 16) * 2048 + bj * 128;
                    float sa[8], ss[8]; unpack8(__builtin_nontemporal_load((const u32x4*)gp), sa); unpack8(*(const u32x4*)(gp + 1024), ss);
                    f32x4 r0, r1;
                    r0[0] = sa[0] * __builtin_amdgcn_rcpf(ss[0]); r0[1] = sa[1] * __builtin_amdgcn_rcpf(ss[1]); r0[2] = sa[2] * __builtin_amdgcn_rcpf(ss[2]); r0[3] = sa[3] * __builtin_amdgcn_rcpf(ss[3]);
                    r1[0] = sa[4] * __builtin_amdgcn_rcpf(ss[4]); r1[1] = sa[5] * __builtin_amdgcn_rcpf(ss[5]); r1[2] = sa[6] * __builtin_amdgcn_rcpf(ss[6]); r1[3] = sa[7] * __builtin_amdgcn_rcpf(ss[7]);
                    acc[ai][bj][m][0] = acc[ai][bj][m][0] * r0; acc[ai][bj][m][1] = acc[ai][bj][m][1] * r1; }
                __builtin_amdgcn_sched_barrier(0); }
    }
    __device__ __forceinline__ void operator()(EPI_ARGS) const {
        EPI_BEGIN
            float ss[8]; unpack8(__builtin_nontemporal_load((const u32x4*)(GATES + (size_t)row * 2048 + 1024 + col)), ss);
#pragma unroll
            for (int j = 0; j < 8; ++j) v[j] *= ss[j];
            *(u32x4*)(MG + (size_t)row * 1024 + col) = pack8(v);
        EPI_END
    }
};
template <int PASS> struct EpiMerge {
    const bf16_t* GATES; bf16_t* MG;
    __device__ __forceinline__ void operator()(EPI_ARGS) const {
        EPI_BEGIN
            float s[8]; unpack8(*(const u32x4*)(GATES + (size_t)row * 2048 + PASS * 1024 + col), s);
            bf16_t* d = MG + (size_t)row * 1024 + col;
            if (PASS == 1) { float o[8]; unpack8(*(const u32x4*)d, o);
#pragma unroll
                for (int j = 0; j < 8; ++j) v[j] = o[j] + s[j] * v[j];
            } else {
#pragma unroll
                for (int j = 0; j < 8; ++j) v[j] = s[j] * v[j];
            }
            *(u32x4*)d = pack8(v);
        EPI_END
    }
};
struct EpiRes {
    const float* base; const float* gate  ; float* out;
    __device__ __forceinline__ void operator()(EPI_ARGS) const {
        EPI_BEGIN
            const int b = row >> 11; const float* gp = gate + b * 6144 + col; const float* bp = base + (size_t)row * 1024 + col; float* op = out + (size_t)row * 1024 + col;
            const f32x4 g0 = *(const f32x4*)gp, g1 = *(const f32x4*)(gp + 4), x0 = *(const f32x4*)bp, x1 = *(const f32x4*)(bp + 4);
            *(f32x4*)op = (f32x4){x0[0] + g0[0] * v[0], x0[1] + g0[1] * v[1], x0[2] + g0[2] * v[2], x0[3] + g0[3] * v[3]};
            *(f32x4*)(op + 4) = (f32x4){x1[0] + g1[0] * v[4], x1[1] + g1[1] * v[5], x1[2] + g1[2] * v[6], x1[3] + g1[3] * v[7]};
        EPI_END
    }
};
struct SchedChain { int c; __device__ bool next(int i, Unit& u) const { if (i >= 16) return false; const int xx = c & 7, k = c >> 3, round = i >> 3, step = i & 7; u.pm = 8 * (4 * xx + (k >> 3)) + step; u.pn = (k & 7) + 8 * round; return true; } };
__device__ __forceinline__ float dpp_ror1(float v) { return __builtin_bit_cast(float, __builtin_amdgcn_update_dpp(__builtin_bit_cast(int, v), __builtin_bit_cast(int, v), 0x121, 0xf, 0xf, false)); }
__device__ __forceinline__ float dpp_ror2(float v) { return __builtin_bit_cast(float, __builtin_amdgcn_update_dpp(__builtin_bit_cast(int, v), __builtin_bit_cast(int, v), 0x122, 0xf, 0xf, false)); }
struct EpiUpConv {
    bf16_t* ACT; const float* w_conv; const float* b_conv; LAS float* xb;
    const float* SSQp; const float* SHWp;
    __device__ __forceinline__ void operator()(f32x4 (&acc)[2][2][4][2], const Unit& u, int wr, int wc, int fr, int fq) const {
        const int colb = wc * 32 + 8 * fq, step = u.pm & 7, par = step & 1;
        { const float* sp = SHWp + (u.pm >> 3) * 4096 + u.pn * 256 + colb; const float* sq = sp + NBATCH * 2 * FF;
          const f32x4 sa0 = *(const f32x4*)sp + *(const f32x4*)sq, sa1 = *(const f32x4*)(sp + 4) + *(const f32x4*)(sq + 4), sv0 = *(const f32x4*)(sp + 128) + *(const f32x4*)(sq + 128), sv1 = *(const f32x4*)(sp + 132) + *(const f32x4*)(sq + 132);
#pragma unroll
          for (int ai = 0; ai < 2; ++ai)
#pragma unroll
              for (int m = 0; m < 4; ++m) { const int row = u.pm * 256 + ai * 128 + wr * 64 + m * 16 + fr; const f32x4 q0 = *(const f32x4*)(SSQp + (size_t)row * 16 + 4 * fq);
                  float tot = (q0[0] + q0[1]) + (q0[2] + q0[3]); tot += __shfl_xor(tot, 16); tot += __shfl_xor(tot, 32);
                  const float rstd = 1.f / sqrtf(tot * (1.f / DM) + EPS);
                  acc[ai][0][m][0] = acc[ai][0][m][0] * rstd + sa0; acc[ai][0][m][1] = acc[ai][0][m][1] * rstd + sa1;
                  acc[ai][1][m][0] = acc[ai][1][m][0] * rstd + sv0; acc[ai][1][m][1] = acc[ai][1][m][1] * rstd + sv1; } }
#pragma unroll
        for (int ai = 0; ai < 2; ++ai) { const int slot = (ai == 0) ? wr : (wr == 0 ? 2 : 4 + par);
            if (fr >= 14) { LAS float* d = xb + (slot * 2 + (fr - 14)) * 128 + colb; *(LAS f32x4*)d = acc[ai][0][3][0]; *(LAS f32x4*)(d + 4) = acc[ai][0][3][1]; } }
        asm volatile("s_waitcnt lgkmcnt(0)" ::: "memory"); __builtin_amdgcn_s_barrier(); asm volatile("" ::: "memory");
        float w0[8], w1[8], w2[8], bc[8];
        { const int j0 = u.pn * 128 + colb;
#pragma unroll
          for (int j = 0; j < 8; ++j) { w0[j] = w_conv[j0 + j]; w1[j] = w_conv[FF + j0 + j]; w2[j] = w_conv[2 * FF + j0 + j]; bc[j] = b_conv[j0 + j]; } }
#pragma unroll
        for (int ai = 0; ai < 2; ++ai) {
            float prev[8];
            { const int src = (ai == 0) ? (wr == 0 ? 4 + (par ^ 1) : 0) : (wr == 0 ? 1 : 2); const bool zero = (ai == 0) && (wr == 0) && (step == 0);
              const LAS float* p = xb + (src * 2 + (fr & 1)) * 128 + colb; const f32x4 p0 = *(const LAS f32x4*)p, p1 = *(const LAS f32x4*)(p + 4);
              prev[0] = zero ? 0.f : p0[0]; prev[1] = zero ? 0.f : p0[1]; prev[2] = zero ? 0.f : p0[2]; prev[3] = zero ? 0.f : p0[3];
              prev[4] = zero ? 0.f : p1[0]; prev[5] = zero ? 0.f : p1[1]; prev[6] = zero ? 0.f : p1[2]; prev[7] = zero ? 0.f : p1[3]; }
#pragma unroll
            for (int m = 0; m < 4; ++m) { const int row = u.pm * 256 + ai * 128 + wr * 64 + m * 16 + fr;
                float cur[8], vv[8], o[8];
                { const f32x4 a0 = acc[ai][0][m][0], a1 = acc[ai][0][m][1], v0 = acc[ai][1][m][0], v1 = acc[ai][1][m][1];
                  cur[0] = a0[0]; cur[1] = a0[1]; cur[2] = a0[2]; cur[3] = a0[3]; cur[4] = a1[0]; cur[5] = a1[1]; cur[6] = a1[2]; cur[7] = a1[3];
                  vv[0] = v0[0]; vv[1] = v0[1]; vv[2] = v0[2]; vv[3] = v0[3]; vv[4] = v1[0]; vv[5] = v1[1]; vv[6] = v1[2]; vv[7] = v1[3]; }
#pragma unroll
                for (int j = 0; j < 8; ++j) { const float r1 = dpp_ror1(cur[j]), q1 = dpp_ror1(prev[j]), r2 = dpp_ror2(cur[j]), q2 = dpp_ror2(prev[j]);
                    const float a1 = (fr == 0) ? q1 : r1, a2 = (fr < 2) ? q2 : r2;
                    const float cv = bc[j] + w0[j] * cur[j] + w1[j] * a1 + w2[j] * a2; o[j] = cv * sigmoidf_(cv) * vv[j]; prev[j] = cur[j]; }
                *(u32x4*)(ACT + (size_t)row * FF + u.pn * 128 + colb) = pack8(o); }
        }
    }
};
struct EpiResNorm {
    const float* base; const float* MODp; const float* g_ffn; bf16_t* Hbf; bf16_t* HBp; float* SSQp;
    __device__ __forceinline__ void operator()(EPI_ARGS) const {
#pragma unroll
        for (int ai = 0; ai < 2; ++ai)
#pragma unroll
            for (int m = 0; m < 4; ++m) { const int row = u.pm * 256 + ai * 128 + wr * 64 + m * 16 + fr, b = row >> 11; float ss = 0.f;
#pragma unroll
                for (int bj = 0; bj < 2; ++bj) { const int col = u.pn * 256 + bj * 128 + wc * 32 + 8 * fq;
                    const f32x4 v0 = acc[ai][bj][m][0], v1 = acc[ai][bj][m][1];
                    const float* mp = MODp + b * 6144 + col; const float* bp = base + (size_t)row * 1024 + col;
                    const f32x4 g0 = *(const f32x4*)(mp + 2048), g1 = *(const f32x4*)(mp + 2048 + 4), x0 = __builtin_nontemporal_load((const f32x4*)bp), x1 = __builtin_nontemporal_load((const f32x4*)(bp + 4));
                    const f32x4 s0 = *(const f32x4*)(mp + 4096), s1 = *(const f32x4*)(mp + 4096 + 4), f0 = *(const f32x4*)(g_ffn + col), f1 = *(const f32x4*)(g_ffn + col + 4);
                    float h[8] = {x0[0] + g0[0] * v0[0], x0[1] + g0[1] * v0[1], x0[2] + g0[2] * v0[2], x0[3] + g0[3] * v0[3], x1[0] + g1[0] * v1[0], x1[1] + g1[1] * v1[1], x1[2] + g1[2] * v1[2], x1[3] + g1[3] * v1[3]};
                    *(u32x4*)(Hbf + (size_t)row * 1024 + col) = pack8(h);
#pragma unroll
                    for (int j = 0; j < 8; ++j) ss += h[j] * h[j];
                    const float gmv[8] = {f0[0] * (1.f + s0[0]), f0[1] * (1.f + s0[1]), f0[2] * (1.f + s0[2]), f0[3] * (1.f + s0[3]), f1[0] * (1.f + s1[0]), f1[1] * (1.f + s1[1]), f1[2] * (1.f + s1[2]), f1[3] * (1.f + s1[3])};
#pragma unroll
                    for (int j = 0; j < 8; ++j) h[j] *= gmv[j];
                    *(u32x4*)(HBp + (size_t)row * 1024 + col) = pack8(h); }
                ss += __shfl_xor(ss, 16); ss += __shfl_xor(ss, 32);
                if (fq == 0) SSQp[(size_t)row * 16 + u.pn * 4 + wc] = ss; }
    }
};
struct EpiRes2 {
    const bf16_t* base; const float* gate  ; bf16_t* H2; float* SSQp;
    __device__ __forceinline__ void operator()(EPI_ARGS) const {
#pragma unroll
        for (int ai = 0; ai < 2; ++ai)
#pragma unroll
            for (int m = 0; m < 4; ++m) { const int row = u.pm * 256 + ai * 128 + wr * 64 + m * 16 + fr, b = row >> 11; float ss = 0.f;
#pragma unroll
                for (int bj = 0; bj < 2; ++bj) { const int col = u.pn * 256 + bj * 128 + wc * 32 + 8 * fq;
                    const f32x4 v0 = acc[ai][bj][m][0], v1 = acc[ai][bj][m][1];
                    const float* gp = gate + b * 6144 + col; float xb[8]; unpack8(*(const u32x4*)(base + (size_t)row * 1024 + col), xb);
                    const f32x4 g0 = *(const f32x4*)gp, g1 = *(const f32x4*)(gp + 4);
                    float h[8] = {xb[0] + g0[0] * v0[0], xb[1] + g0[1] * v0[1], xb[2] + g0[2] * v0[2], xb[3] + g0[3] * v0[3], xb[4] + g1[0] * v1[0], xb[5] + g1[1] * v1[1], xb[6] + g1[2] * v1[2], xb[7] + g1[3] * v1[3]};
#pragma unroll
                    for (int j = 0; j < 8; ++j) ss += h[j] * h[j];
                    *(u32x4*)(H2 + (size_t)row * 1024 + col) = pack8(h); }
                ss += __shfl_xor(ss, 16); ss += __shfl_xor(ss, 32);
                if (fq == 0) SSQp[(size_t)row * 16 + u.pn * 4 + wc] = ss; }
    }
};
struct EpiResFinal {
    const bf16_t* base; const float* gate  ; const float* g_final; float* out; float* XCH; unsigned* CNT; LAS float* misc;
    __device__ __forceinline__ void operator()(f32x4 (&acc)[2][2][4][2], const Unit& u, int wr, int wc, int fr, int fq) const {
        const int tid = (wr * 4 + wc) * 64 + fq * 16 + fr;
        LAS float* part = misc; LAS float* rs = misc + 1024;
#pragma unroll
        for (int ai = 0; ai < 2; ++ai)
#pragma unroll
            for (int m = 0; m < 4; ++m) { const int rl = ai * 128 + wr * 64 + m * 16 + fr, row = u.pm * 256 + rl, b = row >> 11; float ss = 0.f;
#pragma unroll
                for (int bj = 0; bj < 2; ++bj) { const int col = u.pn * 256 + bj * 128 + wc * 32 + 8 * fq;
                    const float* gp = gate + b * 6144 + col; float xb[8]; unpack8(__builtin_nontemporal_load((const u32x4*)(base + (size_t)row * 1024 + col)), xb);
                    const f32x4 g0 = *(const f32x4*)gp, g1 = *(const f32x4*)(gp + 4); f32x4 h0, h1;
                    h0[0] = xb[0] + g0[0] * acc[ai][bj][m][0][0]; h0[1] = xb[1] + g0[1] * acc[ai][bj][m][0][1]; h0[2] = xb[2] + g0[2] * acc[ai][bj][m][0][2]; h0[3] = xb[3] + g0[3] * acc[ai][bj][m][0][3];
                    h1[0] = xb[4] + g1[0] * acc[ai][bj][m][1][0]; h1[1] = xb[5] + g1[1] * acc[ai][bj][m][1][1]; h1[2] = xb[6] + g1[2] * acc[ai][bj][m][1][2]; h1[3] = xb[7] + g1[3] * acc[ai][bj][m][1][3];
                    ss += (h0[0] * h0[0] + h0[1] * h0[1]) + (h0[2] * h0[2] + h0[3] * h0[3]) + (h1[0] * h1[0] + h1[1] * h1[1]) + (h1[2] * h1[2] + h1[3] * h1[3]);
                    acc[ai][bj][m][0] = h0; acc[ai][bj][m][1] = h1; }
                ss += __shfl_xor(ss, 16); ss += __shfl_xor(ss, 32);
                if (fq == 0) part[wc * 256 + rl] = ss; }
        asm volatile("s_waitcnt lgkmcnt(0)" ::: "memory"); __builtin_amdgcn_s_barrier(); asm volatile("" ::: "memory");
        if (tid < 256) { const float tot = (part[tid] + part[256 + tid]) + (part[512 + tid] + part[768 + tid]);
            __hip_atomic_store(XCH + (size_t)(u.pm * 4 + u.pn) * 256 + tid, tot, __ATOMIC_RELAXED, __HIP_MEMORY_SCOPE_AGENT); }
        asm volatile("s_waitcnt vmcnt(0)" ::: "memory"); __builtin_amdgcn_s_barrier(); asm volatile("" ::: "memory");
        if (tid == 0) { __hip_atomic_fetch_add(CNT + u.pm, 1u, __ATOMIC_RELAXED, __HIP_MEMORY_SCOPE_AGENT);
            while (__hip_atomic_load(CNT + u.pm, __ATOMIC_RELAXED, __HIP_MEMORY_SCOPE_AGENT) < 4u) __builtin_amdgcn_s_sleep(1); }
        asm volatile("s_waitcnt vmcnt(0)" ::: "memory"); __builtin_amdgcn_s_barrier(); asm volatile("" ::: "memory");
        if (tid < 256) { const float* xp = XCH + (size_t)(u.pm * 4) * 256 + tid;
            const float t0 = __hip_atomic_load(xp, __ATOMIC_RELAXED, __HIP_MEMORY_SCOPE_AGENT), t1 = __hip_atomic_load(xp + 256, __ATOMIC_RELAXED, __HIP_MEMORY_SCOPE_AGENT),
                        t2 = __hip_atomic_load(xp + 512, __ATOMIC_RELAXED, __HIP_MEMORY_SCOPE_AGENT), t3 = __hip_atomic_load(xp + 768, __ATOMIC_RELAXED, __HIP_MEMORY_SCOPE_AGENT);
            rs[tid] = 1.f / sqrtf(((t0 + t1) + (t2 + t3)) * (1.f / DM) + EPS); }
        asm volatile("s_waitcnt lgkmcnt(0)" ::: "memory"); __builtin_amdgcn_s_barrier(); asm volatile("" ::: "memory");
#pragma unroll
        for (int ai = 0; ai < 2; ++ai)
#pragma unroll
            for (int m = 0; m < 4; ++m) { const int rl = ai * 128 + wr * 64 + m * 16 + fr, row = u.pm * 256 + rl; const float r = rs[rl];
#pragma unroll
                for (int bj = 0; bj < 2; ++bj) { const int col = u.pn * 256 + bj * 128 + wc * 32 + 8 * fq; float* op = out + (size_t)row * 1024 + col;
                    const f32x4 f0 = *(const f32x4*)(g_final + col), f1 = *(const f32x4*)(g_final + col + 4);
                    *(f32x4*)op = acc[ai][bj][m][0] * r * f0; *(f32x4*)(op + 4) = acc[ai][bj][m][1] * r * f1; } }
    }
};
struct EpiUp {
    bf16_t* UP;
    __device__ __forceinline__ void operator()(EPI_ARGS) const {
        EPI_BEGIN
            *(u32x4*)(UP + (size_t)row * 4096 + col) = pack8(v);
        EPI_END
    }
};

template <class Epi, class Sched, int MID_T = -1>
__device__ __forceinline__ void gemm_phase(LAS unsigned char* lds, const Gemm g, const Sched& S, const Epi& E, const int wid, const int lane) {
    const int tid = wid * 64 + lane, wr = wid >> 2, wc = wid & 3, fr = lane & 15, fq = lane >> 4;
    const int K = g.K, nt = K / BK;
    unsigned voffA[2], voffB[2];
#pragma unroll
    for (int i = 0; i < 2; ++i) { int R, C; stage_rc(tid * 16 + i * 8192, R, C); const int Rb = (R & ~31) + perm32(R & 31);
        voffA[i] = (unsigned)(R * g.lda + C) * 2u; voffB[i] = (unsigned)(Rb * g.ldb + C) * 2u; }
    const size_t kstep = (size_t)(BK * 2);
    const size_t hA = (size_t)HALF * g.lda * 2, hB = (size_t)HALF * g.ldb * 2, tA = 2 * hA, tB = 2 * hB;
    const unsigned ldsw = (unsigned)wid * 1024u;
    const int aoff = lds_byte(wr * 64 + fr, fq * 8), boff = lds_byte(wc * 32 + fr, fq * 8);
#define PG8_SA(b, h) (((b) * 2 + (h)) * HTB)
#define PG8_SB(b, h) ((4 + (b) * 2 + (h)) * HTB)
#define PG8_STAGE(bufoff, gbase, voff) do { _Pragma("unroll") for (int _i = 0; _i < 2; ++_i) \
        __builtin_amdgcn_global_load_lds((const GAS unsigned*)((const char*)(gbase) + (voff)[_i]), (LAS unsigned*)(lds + (bufoff) + ldsw + _i * 8192), 16, 0, 0); } while (0)
#define PG8_LDA(dst, b, h) do { _Pragma("unroll") for (int m = 0; m < 4; ++m) _Pragma("unroll") for (int k = 0; k < 2; ++k) dst[m][k] = *(const LAS bf16x8*)(lds + PG8_SA(b, h) + aoff + m * 2048 + k * 1024); } while (0)
#define PG8_LDB(dst, b, h) do { _Pragma("unroll") for (int n = 0; n < 2; ++n) _Pragma("unroll") for (int k = 0; k < 2; ++k) dst[n][k] = *(const LAS bf16x8*)(lds + PG8_SB(b, h) + boff + n * 2048 + k * 1024); } while (0)
#define PG8_MMA(ai, bj, At, Bt) do { __builtin_amdgcn_s_setprio(1); _Pragma("unroll") for (int m = 0; m < 4; ++m) _Pragma("unroll") for (int n = 0; n < 2; ++n) _Pragma("unroll") for (int k = 0; k < 2; ++k) \
        acc[ai][bj][m][n] = __builtin_amdgcn_mfma_f32_16x16x32_bf16(Bt[n][k], At[m][k], acc[ai][bj][m][n], 0, 0, 0); __builtin_amdgcn_s_setprio(0); } while (0)
#define PG8_WAIT_V(n) asm volatile("s_waitcnt vmcnt(" #n ")" ::: "memory")
#define PG8_WAIT_L(n) asm volatile("s_waitcnt lgkmcnt(" #n ")" ::: "memory")
#define PG8_BAR __builtin_amdgcn_s_barrier()
#define PG8_SCHED __builtin_amdgcn_sched_barrier(0)
    Unit cur, nxt; int ui = 0;
    if (!S.next(0, cur)) return;
    f32x4 acc[2][2][4][2];
#pragma unroll
    for (int a = 0; a < 2; ++a)
#pragma unroll
        for (int b = 0; b < 2; ++b)
#pragma unroll
            for (int m = 0; m < 4; ++m)
#pragma unroll
                for (int n = 0; n < 2; ++n) acc[a][b][m][n] = (f32x4){0.f, 0.f, 0.f, 0.f};
    bf16x8 At[4][2], B0[2][2], B1[2][2];
    const char* cA = (const char*)g.A + (size_t)cur.pm * tA; const char* cB = (const char*)g.Bt + (size_t)cur.pn * tB;
    PG8_STAGE(PG8_SB(0, 0), cB, voffB); PG8_STAGE(PG8_SB(0, 1), cB + hB, voffB); PG8_STAGE(PG8_SA(0, 0), cA, voffA); PG8_STAGE(PG8_SA(0, 1), cA + hA, voffA);
    if (wr == 1) PG8_BAR;
    PG8_WAIT_V(2); PG8_BAR;
    PG8_STAGE(PG8_SB(1, 0), cB + kstep, voffB); PG8_STAGE(PG8_SA(1, 0), cA + kstep, voffA); PG8_STAGE(PG8_SB(1, 1), cB + hB + kstep, voffB);
    PG8_WAIT_V(6); PG8_BAR;
    for (;;) {
        const bool has_next = S.next(ui + 1, nxt);
        const char* nA = has_next ? (const char*)g.A + (size_t)nxt.pm * tA : cA; const char* nB = has_next ? (const char*)g.Bt + (size_t)nxt.pn * tB : cB;
        for (int t = 0; t < nt; t += 2) {
            const bool last = (t == nt - 2);
            if constexpr (MID_T >= 0) { if (t == MID_T) E.mid(acc, cur, wr, wc, fr, fq); }
            const char* a1 = cA + (size_t)(t + 1) * kstep;
            const char* a2 = last ? nA : cA + (size_t)(t + 2) * kstep; const char* b2 = last ? nB : cB + (size_t)(t + 2) * kstep;
            const char* a3 = a2 + kstep; const char* b3 = b2 + kstep;
            PG8_LDB(B0, 0, 0); PG8_LDB(B1, 0, 1); PG8_SCHED; PG8_LDA(At, 0, 0); PG8_STAGE(PG8_SA(1, 1), a1 + hA, voffA);
            PG8_WAIT_V(8); PG8_WAIT_L(0); PG8_BAR; PG8_MMA(0, 0, At, B0); PG8_MMA(0, 1, At, B1); PG8_BAR; PG8_SCHED;
            PG8_LDA(At, 0, 1); PG8_STAGE(PG8_SB(0, 0), b2, voffB); PG8_STAGE(PG8_SB(0, 1), b2 + hB, voffB); PG8_STAGE(PG8_SA(0, 0), a2, voffA);
            PG8_WAIT_V(8); PG8_WAIT_L(0); PG8_BAR; PG8_MMA(1, 0, At, B0); PG8_MMA(1, 1, At, B1); PG8_BAR; PG8_SCHED;
            PG8_LDB(B0, 1, 0); PG8_LDB(B1, 1, 1); PG8_SCHED; PG8_LDA(At, 1, 0); PG8_STAGE(PG8_SA(0, 1), a2 + hA, voffA);
            PG8_WAIT_V(8); PG8_WAIT_L(0); PG8_BAR; PG8_MMA(0, 0, At, B0); PG8_MMA(0, 1, At, B1); PG8_BAR; PG8_SCHED;
            PG8_LDA(At, 1, 1); PG8_STAGE(PG8_SB(1, 0), b3, voffB); PG8_STAGE(PG8_SB(1, 1), b3 + hB, voffB); PG8_STAGE(PG8_SA(1, 0), a3, voffA);
            PG8_WAIT_V(8); PG8_WAIT_L(0); PG8_BAR; PG8_MMA(1, 0, At, B0); PG8_MMA(1, 1, At, B1); PG8_BAR; PG8_SCHED;
        }
        if (wr == 0) PG8_BAR;
        E(acc, cur, wr, wc, fr, fq);
        if (!has_next) break;
#pragma unroll
        for (int a = 0; a < 2; ++a)
#pragma unroll
            for (int b = 0; b < 2; ++b)
#pragma unroll
                for (int m = 0; m < 4; ++m)
#pragma unroll
                    for (int n = 0; n < 2; ++n) acc[a][b][m][n] = (f32x4){0.f, 0.f, 0.f, 0.f};
        cur = nxt; cA = nA; cB = nB; ++ui;
        if (wr == 1) PG8_BAR;
    }
    PG8_WAIT_V(0);
    PG8_BAR;
#undef PG8_SA
#undef PG8_SB
#undef PG8_STAGE
#undef PG8_LDA
#undef PG8_LDB
#undef PG8_MMA
#undef PG8_WAIT_V
#undef PG8_WAIT_L
#undef PG8_BAR
#undef PG8_SCHED
}
}

struct Args { const float* in[26]; float* out; unsigned char* ws; int ph_lo, ph_hi, pad0, pad1; };

__device__ __forceinline__ void transpose_item(const float* W, int K, int N, bf16_t* WT, LAS float* scr, int item, int lane, bool perm_up = false, int ldw = 0, int koff = 0) {
    if (ldw == 0) ldw = K;
    const int nblk = N / 32, kb = item / nblk, nb = item % nblk, k0 = 64 * kb, n0 = 32 * nb;
    float tv[32];
#pragma unroll
    for (int i = 0; i < 32; ++i) tv[i] = W[(size_t)(k0 + 2 * i + (lane >> 5)) * N + n0 + (lane & 31)];
#pragma unroll
    for (int i = 0; i < 32; ++i) scr[(2 * i + (lane >> 5)) * 33 + (lane & 31)] = tv[i];
    asm volatile("s_waitcnt lgkmcnt(0)" ::: "memory");
    const int c = lane & 7;
#pragma unroll
    for (int j = 0; j < 4; ++j) { const int n = (lane >> 3) + 8 * j; const LAS float* s = scr + (8 * c) * 33 + n;
        u32x4 o; o.x = cvt_pk_bf16(s[0 * 33], s[1 * 33]); o.y = cvt_pk_bf16(s[2 * 33], s[3 * 33]); o.z = cvt_pk_bf16(s[4 * 33], s[5 * 33]); o.w = cvt_pk_bf16(s[6 * 33], s[7 * 33]);
        int nn = n0 + n; if (perm_up) nn = (nn < FF) ? ((nn >> 7) * 256 + (nn & 127)) : (((nn - FF) >> 7) * 256 + 128 + ((nn - FF) & 127));
        *(u32x4*)(WT + (size_t)nn * ldw + koff + k0 + 8 * c) = o; }
    asm volatile("s_waitcnt lgkmcnt(0)" ::: "memory");
}

template <bool SILU, bool PERM_UP>
__device__ __forceinline__ void gemv32(LAS unsigned char* lds, const float* IN, int in_pitch, const float* W, int N, int c0, const float* bias, float* OUT, int out_pitch, int tid, int wave, int lane, int k_lo = 0, int kw = 128) {
    LAS float* cact = (LAS float*)lds;
    for (int i0 = tid; i0 < NBATCH * DM; i0 += 16 * NTHR) { float t[16];
#pragma unroll
        for (int k = 0; k < 16; ++k) { const int i = i0 + k * NTHR; t[k] = IN[(i >> 10) * in_pitch + (i & 1023)]; }
#pragma unroll
        for (int k = 0; k < 16; ++k) { const int i = i0 + k * NTHR; cact[(i >> 10) * 1025 + (i & 1023)] = SILU ? t[k] * sigmoidf_(t[k]) : t[k]; } }
    __syncthreads();
    typedef float f32x16 __attribute__((ext_vector_type(16)));
    f32x16 macc;
#pragma unroll
    for (int i = 0; i < 16; ++i) macc[i] = 0.f;
    const int kb = k_lo + wave * kw + (lane >> 5), cl = lane & 31;
    const float* wp = W + (size_t)kb * N + c0 + cl; const LAS float* cp = cact + cl * 1025 + kb;
    for (int k0 = 0; k0 < (kw >> 1); k0 += 16) { float wv[16], cv[16];
#pragma unroll
        for (int kk = 0; kk < 16; ++kk) { wv[kk] = wp[(size_t)(k0 + kk) * 2 * N]; cv[kk] = cp[(k0 + kk) * 2]; }
#pragma unroll
        for (int kk = 0; kk < 16; ++kk) macc = __builtin_amdgcn_mfma_f32_32x32x2f32(cv[kk], wv[kk], macc, 0, 0, 0); }
    __syncthreads();
    LAS float* red = (LAS float*)lds;
#pragma unroll
    for (int i = 0; i < 16; ++i) red[(wave * 16 + i) * 64 + lane] = macc[i];
    __syncthreads();
    for (int o = tid; o < 1024; o += NTHR) { float s = 0.f;
#pragma unroll
        for (int w8 = 0; w8 < 8; ++w8) s += red[w8 * 1024 + o];
        const int i = o >> 6, l = o & 63, b = (i & 3) + 8 * (i >> 2) + 4 * (l >> 5), cc = c0 + (l & 31);
        int oc = cc; if (PERM_UP) oc = (cc < FF) ? ((cc >> 7) * 256 + (cc & 127)) : (((cc - FF) >> 7) * 256 + 128 + ((cc - FF) & 127));
        OUT[b * out_pitch + oc] = s + (bias ? bias[cc] : 0.f); }
    __syncthreads();
}

struct cplx { double re, im; };
__device__ __forceinline__ cplx cmul(cplx a, cplx b) { return cplx{a.re * b.re - a.im * b.im, a.re * b.im + a.im * b.re}; }
__device__ __forceinline__ cplx cpow_int(cplx a, int e) { cplx r{1.0, 0.0};
    while (e > 0) { if (e & 1) r = cmul(r, a); a = cmul(a, a); e >>= 1; } return r; }
__device__ __forceinline__ double dexp(double x) {
    const double k = __builtin_rint(x * 1.4426950408889634074); const double r = x - k * 0.693147180559945309417;
    double t = 1.0, s = 1.0;
    for (int i = 1; i <= 22; ++i) { t *= r / (double)i; s += t; }
    const long long bits = ((long long)(1023 + (int)k)) << 52; return s * __builtin_bit_cast(double, bits);
}
__device__ __forceinline__ void dsincos(double x, double& sn, double& cs) {
    const double k = __builtin_rint(x * 0.159154943091895335769); const double r = (x - k * 6.28318530717958623200) - k * 2.4492935982947064e-16;
    const double r2 = r * r; double ts = r, tc = 1.0; sn = r; cs = 1.0;
    for (int i = 1; i <= 16; ++i) { tc *= -r2 / (double)((2 * i - 1) * (2 * i)); cs += tc; ts *= -r2 / (double)((2 * i) * (2 * i + 1)); sn += ts; }
}
struct SsmMode { cplx ab, f; };
__device__ __forceinline__ SsmMode ssm_mode(const float* a_re, const float* a_im, const float* log_dt, int g, int n) {
    const double lr = (double)a_re[g * SN + n], li = (double)a_im[g * SN + n], dt = dexp((double)log_dt[g]);
    const double mag = dexp(lr * dt); double sn, cs; dsincos(li * dt, sn, cs);
    SsmMode mo; mo.ab = cplx{mag * cs, mag * sn};
    const double nr = mo.ab.re - 1.0, ni = mo.ab.im, den = lr * lr + li * li;
    mo.f = cplx{(nr * lr + ni * li) / den, (ni * lr - nr * li) / den};
    return mo;
}

constexpr int AKP = 144, AVP = 160, ASLOT = 128 * (AKP + AVP), ALDS_V = 128 * AKP;
typedef short v4i16_t __attribute__((ext_vector_type(4)));
__device__ __forceinline__ void attn_step_decode(int g, int& p, int& r, int& n) { p = g >> 4; const int q = g & 15; r = q >> (4 - 2 * p); n = q & ((16 >> (2 * p)) - 1); }
__device__ __forceinline__ void attn_load_kv(const bf16_t* QKV, int b, int h, int g, int tid, u32x4 (&kreg)[2], u32x4 (&vreg)[2]) {
    int p, r, n; attn_step_decode(g, p, r, n);
#pragma unroll
    for (int i = 0; i < 2; ++i) { const int cid = tid + 512 * i, row = cid >> 3, cc = cid & 7;
        const bf16_t* src = QKV + ((size_t)(b * 8 + h) * SEQ + ((n * 128 + row) << (2 * p)) + r) * 64 + cc * 8;
        kreg[i] = __builtin_nontemporal_load((const u32x4*)(src + (size_t)M * 512)); vreg[i] = __builtin_nontemporal_load((const u32x4*)(src + (size_t)2 * M * 512)); }
}
__device__ __forceinline__ void attn_load_q(const bf16_t* QKV, int b, int h, int g, int w, int fr, int fq, u32x4 (&qreg)[2]) {
    int p, r, n; attn_step_decode(g, p, r, n);
    const bf16_t* qs = QKV + ((size_t)(b * 8 + h) * SEQ + ((n * 128 + 16 * w + fr) << (2 * p)) + r) * 64 + fq * 8;
    qreg[0] = __builtin_nontemporal_load((const u32x4*)qs); qreg[1] = __builtin_nontemporal_load((const u32x4*)(qs + 32));
}
__device__ __forceinline__ void attn_store_kv(LAS unsigned char* lds, int slot, int tid, const u32x4 (&kreg)[2], const u32x4 (&vreg)[2]) {
#pragma unroll
    for (int i = 0; i < 2; ++i) { const int cid = tid + 512 * i, row = cid >> 3, cc = cid & 7;
        *(LAS u32x4*)(lds + slot * ASLOT + row * AKP + cc * 16) = kreg[i];
        *(LAS u32x4*)(lds + slot * ASLOT + ALDS_V + row * AVP + cc * 16) = vreg[i]; }
}
template <int DUMMY>
__device__ __forceinline__ void attn_step(const int g, LAS unsigned char* lds, const bf16_t* QKV, bf16_t* OY, float* LSE, const int b, const int h, const int w, const int tid, const int fr, const int fq,
                                          const float slope_base, u32x4 (&kreg)[2], u32x4 (&vreg)[2], u32x4 (&qreg)[2]) {
    constexpr int NSTEP = 48;
        asm volatile("s_waitcnt lgkmcnt(0)" ::: "memory"); __builtin_amdgcn_s_barrier(); asm volatile("" ::: "memory");
        if (g + 1 < NSTEP) attn_store_kv(lds, (g + 1) % 3, tid, kreg, vreg);
        int p, r, n; attn_step_decode(g, p, r, n);
        const size_t tok = (size_t)(b * SEQ + ((n * 128 + 16 * w + fr) << (2 * p)) + r);
        bf16_t* op = OY + tok * 768 + h * 64 + 8 * fq; float* lp = LSE + tok * 8 + h;
        u32x4 ro4[2]; float rl = 0.f;
        if (p > 0) { ro4[0] = __builtin_nontemporal_load((const u32x4*)op); ro4[1] = __builtin_nontemporal_load((const u32x4*)(op + 32)); rl = *lp; }
        if (g + 3 < NSTEP) attn_load_kv(QKV, b, h, g + 3, tid, kreg, vreg);
        const bf16x8 q0 = __builtin_bit_cast(bf16x8, qreg[0]), q1 = __builtin_bit_cast(bf16x8, qreg[1]);
        const int sc = g % 3, sp = (g + 2) % 3;
        const float slope2 = slope_base * (float)(1 << (2 * p));
        const int d0 = fr - 4 * fq; const float base = -slope2 * (float)(128 + d0);
        f32x4 sacc[9];
        __builtin_amdgcn_s_setprio(1);
#pragma unroll
        for (int jj = 0; jj < 9; ++jj) { const int jt = w + jj; const float bt = base + ((n > 0 || jt >= 8) ? 0.f : -1.0e30f);
            const LAS unsigned char* kp = lds + (jt >= 8 ? sc : sp) * ASLOT + (16 * (jt & 7) + fr) * AKP + fq * 16;
            const bf16x8 k0 = *(const LAS bf16x8*)kp, k1 = *(const LAS bf16x8*)(kp + 64);
            f32x4 z = (f32x4){bt + slope2 * (float)(16 * jj), bt + slope2 * (float)(16 * jj + 1), bt + slope2 * (float)(16 * jj + 2), bt + slope2 * (float)(16 * jj + 3)};
            z = __builtin_amdgcn_mfma_f32_16x16x32_bf16(k0, q0, z, 0, 0, 0);
            sacc[jj] = __builtin_amdgcn_mfma_f32_16x16x32_bf16(k1, q1, z, 0, 0, 0); }
        __builtin_amdgcn_s_setprio(0);
        if (g + 2 < NSTEP) attn_load_q(QKV, b, h, g + 2, w, fr, fq, qreg);
#pragma unroll
        for (int i = 0; i < 4; ++i) { sacc[0][i] = (i >= d0) ? sacc[0][i] : -1.0e30f; sacc[8][i] = (i <= d0) ? sacc[8][i] : -1.0e30f; }
        float mx = -3.0e38f;
#pragma unroll
        for (int jj = 0; jj < 9; ++jj)
#pragma unroll
            for (int i = 0; i < 4; ++i) mx = fmaxf(mx, sacc[jj][i]);
        mx = fmaxf(mx, __shfl_xor(mx, 16)); mx = fmaxf(mx, __shfl_xor(mx, 32));
        float lsum = 0.f; u32x2 pk[9];
#pragma unroll
        for (int jj = 0; jj < 9; ++jj) { float pp[4];
#pragma unroll
            for (int i = 0; i < 4; ++i) { pp[i] = __builtin_amdgcn_exp2f(sacc[jj][i] - mx); lsum += pp[i]; }
            pk[jj].x = cvt_pk_bf16(pp[0], pp[1]); pk[jj].y = cvt_pk_bf16(pp[2], pp[3]); }
        lsum += __shfl_xor(lsum, 16); lsum += __shfl_xor(lsum, 32);
        f32x4 oacc[4];
#pragma unroll
        for (int et = 0; et < 4; ++et) oacc[et] = (f32x4){0.f, 0.f, 0.f, 0.f};
        __builtin_amdgcn_s_setprio(1);
#pragma unroll
        for (int c = 0; c < 5; ++c) { const int ja = w + 2 * c, jb = (c < 4) ? ja + 1 : ja;
            {
                u32x4 pb; pb.x = pk[2 * c].x; pb.y = pk[2 * c].y; pb.z = (c < 4) ? pk[(c < 4) ? 2 * c + 1 : 0].x : 0u; pb.w = (c < 4) ? pk[(c < 4) ? 2 * c + 1 : 0].y : 0u;
                const bf16x8 pfrag = __builtin_bit_cast(bf16x8, pb);
                const LAS unsigned char* va_p = lds + (ja >= 8 ? sc : sp) * ASLOT + ALDS_V + (16 * (ja & 7) + 4 * fq + (fr >> 2)) * AVP + 16 * (fr & 3);
                const LAS unsigned char* vb_p = lds + (jb >= 8 ? sc : sp) * ASLOT + ALDS_V + (16 * (jb & 7) + 4 * fq + (fr >> 2)) * AVP + 16 * (fr & 3);
#pragma unroll
                for (int et = 0; et < 4; ++et) {
                    const u32x2 va = __builtin_bit_cast(u32x2, __builtin_amdgcn_ds_read_tr16_b64_v4i16((LAS v4i16_t*)(va_p + 64 * (et >> 1) + 8 * (et & 1))));
                    const u32x2 vb = __builtin_bit_cast(u32x2, __builtin_amdgcn_ds_read_tr16_b64_v4i16((LAS v4i16_t*)(vb_p + 64 * (et >> 1) + 8 * (et & 1))));
                    u32x4 vf; vf.x = va.x; vf.y = va.y; vf.z = vb.x; vf.w = vb.y;
                    oacc[et] = __builtin_amdgcn_mfma_f32_16x16x32_bf16(__builtin_bit_cast(bf16x8, vf), pfrag, oacc[et], 0, 0, 0); } } }
        __builtin_amdgcn_s_setprio(0);
        const float lse_n = mx + __builtin_amdgcn_logf(lsum); float ca = 0.f, cb = 1.f / lsum, lse_o = lse_n;
        if (p > 0) { const float mm = fmaxf(rl, lse_n), wr_ = __builtin_amdgcn_exp2f(rl - mm), wn_ = __builtin_amdgcn_exp2f(lse_n - mm), den = wr_ + wn_, rd = 1.f / den;
            ca = wr_ * rd; cb = wn_ * rd * cb; lse_o = mm + __builtin_amdgcn_logf(den); }
#pragma unroll
        for (int hf = 0; hf < 2; ++hf) { float o[8];
#pragma unroll
            for (int j = 0; j < 8; ++j) o[j] = oacc[2 * hf + (j >> 2)][j & 3] * cb;
            if (p > 0) { float rr[8]; unpack8(ro4[hf], rr);
#pragma unroll
                for (int j = 0; j < 8; ++j) o[j] += ca * rr[j]; }
            *(u32x4*)(op + 32 * hf) = pack8(o); }
        if (fq == 0 && p < 2) *lp = lse_o;
}

__device__ __forceinline__ void attn_phase(LAS unsigned char* lds, const bf16_t* QKV, bf16_t* OY, float* LSE, int bh, const int w, const int lane) {
    const int tid = w * 64 + lane, fr = lane & 15, fq = lane >> 4, b = bh >> 3, h = bh & 7;
    constexpr int NSTEP = 48;
    u32x4 kA[2], vA[2], kB[2], vB[2], qE[2], qO[2];
    for (int i = tid; i < ASLOT / 16; i += NTHR) *(LAS u32x4*)(lds + 2 * ASLOT + i * 16) = (u32x4){0u, 0u, 0u, 0u};
    attn_load_kv(QKV, b, h, 0, tid, kB, vB);
    attn_load_q(QKV, b, h, 0, w, fr, fq, qE);
    attn_store_kv(lds, 0, tid, kB, vB);
    attn_load_kv(QKV, b, h, 1, tid, kA, vA);
    attn_load_q(QKV, b, h, 1, w, fr, fq, qO);
    attn_load_kv(QKV, b, h, 2, tid, kB, vB);
    const float slope_base = __builtin_amdgcn_exp2f(-(float)(h + 1)) * LOG2E;
#pragma unroll 1
    for (int g = 0; g < NSTEP; g += 2) {
        attn_step<0>(g, lds, QKV, OY, LSE, b, h, w, tid, fr, fq, slope_base, kA, vA, qE);
        attn_step<1>(g + 1, lds, QKV, OY, LSE, b, h, w, tid, fr, fq, slope_base, kB, vB, qO);
    }
    __syncthreads();
}

__device__ __forceinline__ int lds_grab(LAS int* ctr, int lane) { int c = 0; if (lane == 0) c = __hip_atomic_fetch_add((int*)ctr, 1, __ATOMIC_RELAXED, __HIP_MEMORY_SCOPE_WORKGROUP); return __builtin_amdgcn_readfirstlane(c); }
__device__ __forceinline__ void modnorm_rows(const float* X, const float* gw, const float* MOD, int sh_off, int sc_off, bf16_t* XN, int row_base, int nrows, LAS int* ctr, int lane) {
    const int b = row_base >> 11, nchunk = nrows >> 2;
    f32x4 gm[4], shv[4];
    { const float* mp = MOD + b * 6144 + 4 * lane;
#pragma unroll
      for (int j = 0; j < 4; ++j) { const f32x4 g4 = *(const f32x4*)(gw + 4 * lane + 256 * j), sc = *(const f32x4*)(mp + sc_off + 256 * j); shv[j] = *(const f32x4*)(mp + sh_off + 256 * j);
          gm[j] = (f32x4){g4[0] * (1.f + sc[0]), g4[1] * (1.f + sc[1]), g4[2] * (1.f + sc[2]), g4[3] * (1.f + sc[3])}; } }
    int ch = lds_grab(ctr, lane);
    if (ch >= nchunk) return;
    f32x4 v[4][4], nv[4][4];
#pragma unroll
    for (int q = 0; q < 4; ++q) { const f32x4* xr = (const f32x4*)(X + (size_t)(row_base + 4 * ch + q) * DM) + lane;
#pragma unroll
        for (int j = 0; j < 4; ++j) v[q][j] = __builtin_nontemporal_load(xr + 64 * j); }
    for (;;) {
        const int nch = lds_grab(ctr, lane); const bool more = nch < nchunk; const int pch = more ? nch : ch;
#pragma unroll
        for (int q = 0; q < 4; ++q) { const f32x4* xr = (const f32x4*)(X + (size_t)(row_base + 4 * pch + q) * DM) + lane;
#pragma unroll
            for (int j = 0; j < 4; ++j) nv[q][j] = __builtin_nontemporal_load(xr + 64 * j); }
#pragma unroll
        for (int q = 0; q < 4; ++q) { const int row = row_base + 4 * ch + q; float s = 0.f;
#pragma unroll
            for (int j = 0; j < 4; ++j) s += (v[q][j][0] * v[q][j][0] + v[q][j][1] * v[q][j][1]) + (v[q][j][2] * v[q][j][2] + v[q][j][3] * v[q][j][3]);
            const float rstd = 1.f / sqrtf(wave_sum(s) * (1.f / DM) + EPS);
#pragma unroll
            for (int j = 0; j < 4; ++j) { float o[4];
#pragma unroll
                for (int e = 0; e < 4; ++e) o[e] = (v[q][j][e] * rstd) * gm[j][e] + shv[j][e];
                u32x2 pkd; pkd.x = cvt_pk_bf16(o[0], o[1]); pkd.y = cvt_pk_bf16(o[2], o[3]);
                *(u32x2*)(XN + (size_t)row * DM + 4 * lane + 256 * j) = pkd; } }
        if (!more) break;
        ch = nch;
#pragma unroll
        for (int q = 0; q < 4; ++q)
#pragma unroll
            for (int j = 0; j < 4; ++j) v[q][j] = nv[q][j];
    }
}

constexpr int TI_IN = (DM / 64) * (INW / 32), TI_PA = (AW / 64) * (DM / 32), TI_PS = (SW / 64) * (DM / 32), TI_GLU = (SW / 64) * (SW / 32), TI_OUT = (DM / 64) * (DM / 32),
              TI_UP = (DM / 64) * (2 * FF / 32), TI_DN = (FF / 64) * (DM / 32), NIT = TI_IN + TI_PA + TI_PS + TI_GLU + TI_OUT + TI_UP + TI_DN, NIT0 = 2048;
typedef const __attribute__((address_space(4))) Args* KArgs;
__device__ __forceinline__ void transpose_any(KArgs ka, int it, LAS float* scr, int lane) {
    unsigned char* wsb = ka->ws; int r = it;
    if (r < TI_IN) { transpose_item(ka->in[5], DM, INW, (bf16_t*)(wsb + WS_WIN), scr, r, lane); return; } r -= TI_IN;
    if (r < TI_PA) { transpose_item(ka->in[17], AW, DM, (bf16_t*)(wsb + WS_WPA), scr, r, lane, false, AW + SW, 0); return; } r -= TI_PA;
    if (r < TI_PS) { transpose_item(ka->in[18], SW, DM, (bf16_t*)(wsb + WS_WPA), scr, r, lane, false, AW + SW, AW); return; } r -= TI_PS;
    if (r < TI_GLU) { transpose_item(ka->in[15], SW, SW, (bf16_t*)(wsb + WS_WGLU), scr, r, lane); return; } r -= TI_GLU;
    if (r < TI_OUT) { transpose_item(ka->in[19], DM, DM, (bf16_t*)(wsb + WS_WOUT), scr, r, lane); return; } r -= TI_OUT;
    if (r < TI_UP) { transpose_item(ka->in[21], DM, 2 * FF, (bf16_t*)(wsb + WS_WUP), scr, r, lane, true); return; } r -= TI_UP;
    transpose_item(ka->in[24], FF, DM, (bf16_t*)(wsb + WS_WDN), scr, r, lane);
}

#define XB_TMO      128
#define XB_XCNT(j)  (256  + 64 * (j))
#define XB_XSUB(j)  (1280 + 64 * (j))
#define XB_XGEN(j)  (2304 + 64 * (j))
#define XB_TOP      3328
#define XB_TOPGEN   3392
#define XCD_BAR_WORDS 3456
#define XB_SPIN_CAP (1u << 22)
__device__ __forceinline__ unsigned xb_ld(unsigned* p)              { return __hip_atomic_load(p, __ATOMIC_RELAXED, __HIP_MEMORY_SCOPE_AGENT); }
__device__ __forceinline__ unsigned xb_add(unsigned* p, unsigned v) { return __hip_atomic_fetch_add(p, v, __ATOMIC_RELAXED, __HIP_MEMORY_SCOPE_AGENT); }
__device__ __forceinline__ unsigned xb_xcc_id() { return (unsigned)__builtin_amdgcn_s_getreg((3 << 11) | 20) & 0xFu; }
#define XB_SPIN(cond, bar) do { unsigned _sp = 0; while (cond) { __builtin_amdgcn_s_sleep(1); \
    if ((++_sp & 255u) == 0u) { if (xb_ld(&(bar)[XB_TMO])) break; if (_sp > XB_SPIN_CAP) { atomicAdd(&(bar)[XB_TMO], 1u); break; } } } } while (0)
__device__ __forceinline__ void xcd_barrier_complete(unsigned* bar, unsigned x, unsigned G, unsigned& nloc, unsigned& nx) {
    unsigned sum, cnt, mine, sp = 0u;
    for (;;) {
        sum = 0u; cnt = 0u; mine = 0u;
#pragma unroll
        for (unsigned j = 0; j < 16; ++j) { const unsigned c = xb_ld(&bar[XB_XCNT(j)]); sum += c; cnt += (c > 0u) ? 1u : 0u; mine = (j == x) ? c : mine; }
        if (sum == G) break;
        __builtin_amdgcn_s_sleep(1);
        if ((++sp & 255u) == 0u) { if (xb_ld(&bar[XB_TMO])) break; if (sp > XB_SPIN_CAP) { atomicAdd(&bar[XB_TMO], 1u); break; } }
    }
    nloc = mine > 0u ? mine : 1u; nx = cnt > 0u ? cnt : 1u;
}
__device__ __forceinline__ void grid_barrier(unsigned* bar, unsigned x, volatile LAS unsigned* st, unsigned G, int wave) {
    asm volatile("s_waitcnt vmcnt(0)" ::: "memory");
    __syncthreads();
    if (wave == 0) {
        int z_; asm volatile("s_mov_b32 %0, 0" : "=s"(z_));
        if ((int)__builtin_amdgcn_mbcnt_hi(~0u, __builtin_amdgcn_mbcnt_lo(~0u, (unsigned)z_)) == 0) {
            __builtin_amdgcn_s_waitcnt(0);
            unsigned nloc = st[0], nx = st[1];
            if (nloc == 0u) { xcd_barrier_complete(bar, x, G, nloc, nx); st[0] = nloc; st[1] = nx; }
            const unsigned old = xb_add(&bar[XB_XSUB(x)], 1u);
            const unsigned gen = old / nloc;
            if (old + 1u == (gen + 1u) * nloc) {
                __builtin_amdgcn_fence(__ATOMIC_RELEASE, "agent");
                asm volatile("s_waitcnt vmcnt(0)" ::: "memory");
                const unsigned og = xb_add(&bar[XB_TOP], 1u);
                const unsigned tg = og / nx;
                if (og + 1u == (tg + 1u) * nx) xb_add(&bar[XB_TOPGEN], 1u);
                else XB_SPIN(xb_ld(&bar[XB_TOPGEN]) == tg, bar);
                __builtin_amdgcn_fence(__ATOMIC_ACQUIRE, "agent");
                xb_add(&bar[XB_XGEN(x)], 1u);
                asm volatile("s_waitcnt vmcnt(0)" ::: "memory");
            } else {
                XB_SPIN(xb_ld(&bar[XB_XGEN(x)]) == gen, bar);
                __builtin_amdgcn_fence(__ATOMIC_ACQUIRE, "agent");
                asm volatile("s_waitcnt vmcnt(0)" ::: "memory");
            }
        }
    }
    __syncthreads();
}

__global__ void __launch_bounds__(NTHR, 2) fwd(Args a) {
    __builtin_assume(__builtin_amdgcn_workitem_id_y() == 0); __builtin_assume(__builtin_amdgcn_workitem_id_z() == 0);
    extern __shared__ __attribute__((aligned(16))) unsigned char lds_raw[];
    LAS unsigned char* lds = (LAS unsigned char*)lds_raw;
    const int wave = __builtin_amdgcn_readfirstlane((int)threadIdx.x >> 6);
    const int G = gridDim.x, bx = blockIdx.x;
    const int vcu = (G % 8 == 0) ? (bx % 8) * (G / 8) + bx / 8 : bx;
    const int gwave = vcu * NWAVES + wave, ngw = G * NWAVES;
    const int ngt = G * NTHR;
    const KArgs ka = (KArgs)__builtin_amdgcn_kernarg_segment_ptr();
#define ws (ka->ws)
#define x (ka->in[0])
#define cvec (ka->in[1])
#define w_ada (ka->in[2])
#define b_ada (ka->in[3])
#define g_mix (ka->in[4])
#define w_in (ka->in[5])
#define b_gate (ka->in[6])
#define a_re (ka->in[7])
#define a_im (ka->in[8])
#define log_dt (ka->in[9])
#define b_re (ka->in[10])
#define b_im (ka->in[11])
#define c_re (ka->in[12])
#define c_im (ka->in[13])
#define d_skip (ka->in[14])
#define w_glu (ka->in[15])
#define b_glu (ka->in[16])
#define w_pa (ka->in[17])
#define w_ps (ka->in[18])
#define w_out (ka->in[19])
#define g_ffn (ka->in[20])
#define w_up (ka->in[21])
#define w_conv (ka->in[22])
#define b_conv (ka->in[23])
#define w_down (ka->in[24])
#define g_final (ka->in[25])
#define out (ka->out)
#define MOD ((float*)(ws + WS_MOD))
#define KS ((float*)(ws + WS_KS))
#define ATC ((float*)(ws + WS_ATC))
#define MODE ((double*)(ws + WS_MODE))
#define PW ((double*)(ws + WS_PW))
#define WIN ((bf16_t*)(ws + WS_WIN))
#define WPA ((bf16_t*)(ws + WS_WPA))
#define WPS ((bf16_t*)(ws + WS_WPS))
#define WGLU ((bf16_t*)(ws + WS_WGLU))
#define WOUT ((bf16_t*)(ws + WS_WOUT))
#define WUP ((bf16_t*)(ws + WS_WUP))
#define WDN ((bf16_t*)(ws + WS_WDN))
#define WST ((bf16_t*)(ws + WS_WST))
#define KW ((bf16_t*)(ws + WS_KW))
#define SLOC4 ((float*)(ws + WS_SLOC4))
#define LSE ((float*)(ws + WS_LSE))
#define XN ((bf16_t*)(ws + WS_XN))
#define QKV ((bf16_t*)(ws + WS_QKV))
#define OATT ((bf16_t*)(ws + WS_OATT))
#define Y2 ((bf16_t*)(ws + WS_Y2))
#define YG ((bf16_t*)(ws + WS_YG))
#define GATES ((bf16_t*)(ws + WS_GATES))
#define UX ((bf16_t*)(ws + WS_UX))
#define OP ((bf16_t*)(ws + WS_OP))
#define UP ((bf16_t*)(ws + WS_UP))
#define HB ((bf16_t*)(ws + WS_HB))
#define HBF ((bf16_t*)(ws + WS_HBF))
#define SSQ ((float*)(ws + WS_SSQ))
#define SHW ((float*)(ws + WS_SHW))
    const int lo = ka->ph_lo, hi = ka->ph_hi;
#ifndef PHMASK
#define PHMASK 0xffff
#endif
#define IN(k) (((PHMASK >> (k)) & 1) && lo <= (k) && (k) < hi)
#define IDS() int z_; asm volatile("s_mov_b32 %0, 0" : "=s"(z_)); const int lane = (int)__builtin_amdgcn_mbcnt_hi(~0u, __builtin_amdgcn_mbcnt_lo(~0u, (unsigned)z_)); const int tid = wave * 64 + lane; const int gthr = vcu * NTHR + tid; (void)gthr; (void)tid
    if (lo < 0) cg::this_grid().sync();
    unsigned* const xbar = (unsigned*)(ws + 16384); const unsigned xcc = xb_xcc_id();
    volatile LAS unsigned* const xst = (volatile LAS unsigned*)(lds + 147456 - 64);
    if (__builtin_amdgcn_workitem_id_x() == 0) { xst[0] = 0u; xst[1] = 0u; (void)xb_add(&xbar[XB_XCNT(xcc)], 1u); }
    __syncthreads();
#define SEAM(k) do { if (IN(k) && IN((k) + 1)) grid_barrier(xbar, xcc, xst, (unsigned)G, wave); } while (0)

    if (IN(0)) { IDS();
        if (bx < 192) gemv32<true, false>(lds, cvec, DM, w_ada, 6 * DM, bx * 32, b_ada, MOD, 6 * DM, tid, wave, lane);
        else {
            if (tid < 16) { const int it = (bx - 192) * 16 + tid, g = it >> 6, n = it & 63;
                const SsmMode mo = ssm_mode(a_re, a_im, log_dt, g, n);
                double* md = MODE + (size_t)it * 4; md[0] = mo.ab.re; md[1] = mo.ab.im; md[2] = mo.f.re; md[3] = mo.f.im;
                double* pw = PW + (size_t)it * 130; cplx p{1.0, 0.0};
                for (int t = 0; t <= TCH; ++t) { pw[2 * t] = p.re; pw[2 * t + 1] = p.im; p = cmul(p, mo.ab); }
                ATC[it * 2] = (float)pw[2 * TCH]; ATC[it * 2 + 1] = (float)pw[2 * TCH + 1]; }
            LAS float* scr = (LAS float*)(lds + wave * 16384);
            for (int it = (bx - 192) * NWAVES + wave; it < NIT0; it += 64 * NWAVES) transpose_any(ka, it, scr, lane);
        }
    }
    SEAM(0);
    if (IN(1)) { IDS();
        { LAS float* scr = (LAS float*)(lds + wave * 16384);
          for (int it = NIT0 + gwave; it < NIT; it += ngw) transpose_any(ka, it, scr, lane); }
        LAS int* ctr = (LAS int*)(lds + 131072 + 8192);
        if (tid == 0) *ctr = 0;
        __syncthreads();
        if (wave == 7) { const int it = vcu * 64 + lane, g = it >> 10, tau = (it >> 4) & 63, c = it & 15;
            double kacc[16];
#pragma unroll
            for (int j = 0; j < 16; ++j) kacc[j] = 0.0;
            for (int n = 0; n < SN; ++n) { const double* md = MODE + (size_t)(g * SN + n) * 4; const double* pw = PW + (size_t)(g * SN + n) * 130 + 2 * tau;
                const cplx cc = cplx{(double)c_re[(g * SC + c) * SN + n], (double)c_im[(g * SC + c) * SN + n]}; const cplx ca = cmul(cmul(cc, cplx{pw[0], pw[1]}), cplx{md[2], md[3]});
#pragma unroll
                for (int j = 0; j < 16; ++j) { const double br = (double)b_re[(g * SN + n) * SC + j], bi = (double)b_im[(g * SN + n) * SC + j]; kacc[j] += ca.re * br - ca.im * bi; } }
#pragma unroll
            for (int j = 0; j < 16; ++j) KS[(size_t)it * 16 + j] = (float)kacc[j]; }
        if (wave >= 3 && wave < 7) { const int it = ((wave - 3) * G + vcu) * 64 + lane, g = it >> 12, n = (it >> 6) & 63, s = it & 63;
            const double* md = MODE + (size_t)(g * SN + n) * 4; const double* pwt = PW + (size_t)(g * SN + n) * 130; const cplx fm{md[2], md[3]};
            { const cplx pf = cmul(cplx{pwt[2 * (TCH - 1 - s)], pwt[2 * (TCH - 1 - s) + 1]}, fm); float wre[16], wim[16];
#pragma unroll
              for (int j = 0; j < 16; ++j) { const double br = (double)b_re[(g * SN + n) * SC + j], bi = (double)b_im[(g * SN + n) * SC + j]; wre[j] = (float)(pf.re * br - pf.im * bi); wim[j] = (float)(pf.re * bi + pf.im * br); }
              bf16_t* d0 = WST + (size_t)(g * 256 + n) * 1024 + s * 16; bf16_t* d1 = d0 + (size_t)64 * 1024;
              *(u32x4*)d0 = pack8(wre); *(u32x4*)(d0 + 8) = pack8(wre + 8); *(u32x4*)d1 = pack8(wim); *(u32x4*)(d1 + 8) = pack8(wim + 8);
              bf16_t* z0 = d0 + (size_t)128 * 1024; bf16_t* z1 = d1 + (size_t)128 * 1024; const u32x4 zz = (u32x4){0u, 0u, 0u, 0u};
              *(u32x4*)z0 = zz; *(u32x4*)(z0 + 8) = zz; *(u32x4*)z1 = zz; *(u32x4*)(z1 + 8) = zz; }
            { const int i = s; const cplx pw{pwt[2 * (i + 1)], pwt[2 * (i + 1) + 1]};
              for (int c = 0; c < SC; ++c) { const cplx cc = cplx{(double)c_re[(g * SC + c) * SN + n], (double)c_im[(g * SC + c) * SN + n]}; const cplx ca = cmul(cc, pw);
                  bf16_t* d = KW + (size_t)(g * 1024 + i * 16 + c) * KX + 1024 + n;
                  d[0] = (bf16_t)(cvt_pk_bf16((float)ca.re, 0.f) & 0xffffu); d[64] = (bf16_t)(cvt_pk_bf16((float)(-ca.im), 0.f) & 0xffffu); } }
        }
        modnorm_rows(x, g_mix, MOD, 0, 1024, XN, vcu * (M / G), M / G, ctr, lane);
    }
    SEAM(1);
    if (IN(2)) { IDS();
        pg8::Gemm g{XN, WIN, DM, DM, DM}; pg8::StaticOrder S; S.init(M, INW, G, bx);
        pg8::EpiInProj E{QKV, UX, GATES, b_gate};
        pg8::gemm_phase(lds, g, S, E, wave, lane);
    }
    SEAM(2);
    if (IN(3)) { IDS();
        { const int kq = bx & 3; pg8::Gemm g{UX + kq * 256, WST + kq * 256, KX, 1024, 256}; pg8::SchedS1 S{bx}; pg8::EpiS1 E{SLOC4 + (size_t)kq * (SG * 1024 * 128)}; pg8::gemm_phase(lds, g, S, E, wave, lane); }
        attn_phase(lds, QKV, OATT, LSE, bx, wave, lane);
        for (int it = gthr; it < SG * TCH * SC * TCH; it += ngt) { const int g = it >> 16, i = (it >> 10) & 63, c = (it >> 6) & 15, s = it & 63;
            u32x4 o0 = (u32x4){0u, 0u, 0u, 0u}, o1 = o0;
            if (s <= i) { const float* kp = KS + ((size_t)((g * 64 + (i - s)) * 16 + c)) * 16; float kv[16];
#pragma unroll
                for (int j = 0; j < 16; ++j) kv[j] = kp[j];
                o0 = pack8(kv); o1 = pack8(kv + 8); }
            bf16_t* d = KW + (size_t)(g * 1024 + i * 16 + c) * KX + s * 16; *(u32x4*)d = o0; *(u32x4*)(d + 8) = o1; }
    }
    SEAM(3);
    if (IN(5)) { IDS();
        {
            const int g = bx >> 4, pmm = (bx >> 2) & 3, bl = tid >> 6, n = tid & 63; constexpr size_t PS = (size_t)SG * 1024 * 128;
            const float ar = ATC[(g * SN + n) * 2], ai = ATC[(g * SN + n) * 2 + 1]; float xr = 0.f, xi = 0.f;
            for (int c8 = 0; c8 < NCH; c8 += 8) { float sr[8], si[8];
#pragma unroll
                for (int q = 0; q < 8; ++q) { const size_t rowi = (size_t)(g * 1024 + pmm * 256 + bl * NCH + c8 + q); const float* sp0 = SLOC4 + rowi * 128 + n;
                    sr[q] = (sp0[0] + sp0[PS]) + (sp0[2 * PS] + sp0[3 * PS]); si[q] = (sp0[64] + sp0[PS + 64]) + (sp0[2 * PS + 64] + sp0[3 * PS + 64]); }
#pragma unroll
                for (int q = 0; q < 8; ++q) { const size_t rowi = (size_t)(g * 1024 + pmm * 256 + bl * NCH + c8 + q);
                    bf16_t* d = UX + rowi * KX + 1024 + n; d[0] = (bf16_t)(cvt_pk_bf16(xr, 0.f) & 0xffffu); d[64] = (bf16_t)(cvt_pk_bf16(xi, 0.f) & 0xffffu);
                    const float nr = ar * xr - ai * xi + sr[q], ni = ar * xi + ai * xr + si[q]; xr = nr; xi = ni; } }
            asm volatile("s_waitcnt vmcnt(0)" ::: "memory"); __syncthreads();
        }
        pg8::Gemm g{UX, KW, KX, KX, KX}; pg8::SchedS3 S{G, bx}; pg8::EpiS3 E{UX, d_skip, Y2}; pg8::gemm_phase(lds, g, S, E, wave, lane); }
    SEAM(5);
    if (IN(6)) { IDS(); pg8::Gemm g{Y2, WGLU, SW, SW, SW}; pg8::StaticOrder S; S.init(M, SW, G, bx); pg8::EpiGlu E{Y2, b_glu, OATT}; pg8::gemm_phase(lds, g, S, E, wave, lane);
        gemv32<false, true>(lds, MOD + 3072, 6 * DM, w_up, 2 * FF, (bx >> 1) * 32, nullptr, SHW + (bx & 1) * (NBATCH * 2 * FF), 2 * FF, tid, wave, lane, (bx & 1) * 512, 64); }
    SEAM(6);
    if (IN(7)) { IDS();
        pg8::Gemm g{OATT, WPA, AW + SW, AW + SW, AW + SW}; pg8::StaticOrder S; S.init(M, DM, G, bx); pg8::EpiMerge1 E{GATES, XN};
        pg8::gemm_phase<pg8::EpiMerge1, pg8::StaticOrder, 8>(lds, g, S, E, wave, lane);
    }
    SEAM(7);
    if (IN(8)) { IDS(); pg8::Gemm g{XN, WOUT, DM, DM, DM}; pg8::StaticOrder S; S.init(M, DM, G, bx); pg8::EpiResNorm E{x, MOD, g_ffn, HBF, HB, SSQ}; pg8::gemm_phase(lds, g, S, E, wave, lane); }
    SEAM(8);
    if (IN(10)) { IDS(); pg8::Gemm g{HB, WUP, DM, DM, DM}; pg8::SchedChain S{bx}; pg8::EpiUpConv E{UP, w_conv, b_conv, (LAS float*)(lds + 131072), SSQ, SHW}; pg8::gemm_phase(lds, g, S, E, wave, lane); }
    SEAM(10);
    if (IN(12)) { IDS(); pg8::Gemm g{UP, WDN, FF, FF, FF}; pg8::StaticOrder S; S.init(M, DM, G, bx); pg8::EpiResFinal E{HBF, MOD + 5120, g_final, out, (float*)(ws + WS_XCH), (unsigned*)(ws + WS_CNT), (LAS float*)(lds + 131072 + 8192)}; pg8::gemm_phase(lds, g, S, E, wave, lane); }
#undef IN
#undef SEAM
}
#undef ws
#undef HBF
#undef SLOC4
#undef HB
#undef SSQ
#undef SHW
#undef MODE
#undef PW
#undef x
#undef cvec
#undef w_ada
#undef b_ada
#undef g_mix
#undef w_in
#undef b_gate
#undef a_re
#undef a_im
#undef log_dt
#undef b_re
#undef b_im
#undef c_re
#undef c_im
#undef d_skip
#undef w_glu
#undef b_glu
#undef w_pa
#undef w_ps
#undef w_out
#undef g_ffn
#undef w_up
#undef w_conv
#undef b_conv
#undef w_down
#undef g_final
#undef out
#undef MOD
#undef KS
#undef ATC
#undef WIN
#undef WPA
#undef WPS
#undef WGLU
#undef WOUT
#undef WUP
#undef WDN
#undef WST
#undef KW
#undef SLOC
#undef LSE
#undef XN
#undef QKV
#undef OATT
#undef Y2
#undef YG
#undef GATES
#undef UX
#undef OP
#undef UP

constexpr int N_PHASES = 14;
constexpr int LDS_BYTES = 147456;
extern "C" void kernel_launch(void* const* d_in, const int* in_sizes, int n_in, void* d_out, int out_size, void* d_ws, size_t ws_size, hipStream_t stream) {
    static int grid = 0;
    if (grid == 0) {
        if (n_in != 26 || in_sizes[0] != M * DM || out_size != M * DM || ws_size < WS_END) { fprintf(stderr, "kernel_launch: unexpected shapes (n_in %d in0 %d out %d ws %zu)\n", n_in, n_in > 0 ? in_sizes[0] : -1, out_size, ws_size); grid = -1; return; }
        int dev = 0, cus = 0, per_cu = 0;
        (void)hipGetDevice(&dev); (void)hipDeviceGetAttribute(&cus, hipDeviceAttributeMultiprocessorCount, dev);
        if (hipFuncSetAttribute((const void*)fwd, hipFuncAttributeMaxDynamicSharedMemorySize, LDS_BYTES) != hipSuccess) { fprintf(stderr, "kernel_launch: hipFuncSetAttribute failed\n"); grid = -1; return; }
        if (hipOccupancyMaxActiveBlocksPerMultiprocessor(&per_cu, (const void*)fwd, NTHR, LDS_BYTES) != hipSuccess || per_cu < 1) { fprintf(stderr, "kernel_launch: occupancy query says %d\n", per_cu); per_cu = 1; }
        (void)hipGetLastError();
        grid = cus * 1;
        if (grid != 256) { fprintf(stderr, "kernel_launch: built for a 256-CU device (got %d)\n", cus); grid = -1; return; }
        fprintf(stderr, "kernel_launch: grid %d (cus %d, per_cu %d)\n", grid, cus, per_cu);
    }
    if (grid < 0) return;
    (void)hipMemsetAsync(d_ws, 0, 32768, stream);
    Args a{};
    for (int i = 0; i < 26; ++i) a.in[i] = (const float*)d_in[i];
    a.out = (float*)d_out; a.ws = (unsigned char*)d_ws;
#if MK_SINGLE
    a.ph_lo = 0; a.ph_hi = N_PHASES;
    { void* args[] = {&a}; hipError_t e = hipLaunchCooperativeKernel((const void*)fwd, dim3(grid), dim3(NTHR), args, LDS_BYTES, stream);
      if (e != hipSuccess) fprintf(stderr, "cooperative launch failed: %s\n", hipGetErrorString(e)); }
#else
    for (int ph = 0; ph < N_PHASES; ++ph) for (int rep = 0; rep < (((PROBE_MASK >> ph) & 1) ? 1 + PROBE_REPS : 1); ++rep) { a.ph_lo = ph; a.ph_hi = ph + 1; void* args[] = {&a};
        hipError_t e = hipLaunchCooperativeKernel((const void*)fwd, dim3(grid), dim3(NTHR), args, LDS_BYTES, stream);
        if (e != hipSuccess) { fprintf(stderr, "cooperative launch %d failed: %s\n", ph, hipGetErrorString(e)); break; } }
#endif
}
```

```cpp
#include <hip/hip_runtime.h>
#include <hip/hip_cooperative_groups.h>
#include <cstdio>
#include <cstdint>
namespace cg = cooperative_groups;

#ifndef MK_SINGLE
#define MK_SINGLE 1
#endif

#ifndef PROBE_MASK
#define PROBE_MASK 0x000
#endif
#ifndef PROBE_REPS
#define PROBE_REPS 1
#endif
#define LAS __attribute__((address_space(3)))
#define GAS __attribute__((address_space(1)))
typedef unsigned short bf16_t;
typedef short bf16x8 __attribute__((ext_vector_type(8)));
typedef float f32x4 __attribute__((ext_vector_type(4)));
typedef unsigned u32x4 __attribute__((ext_vector_type(4)));
typedef unsigned u32x2 __attribute__((ext_vector_type(2)));

constexpr int DM = 1024, NBATCH = 32, SEQ = 2048, M = NBATCH * SEQ, NH = 8, HD = 64, AW = 512, SW = 256;
constexpr int SG = 16, SC = 16, SN = 64, FF = 2048, INW = 3840, TCH = 64  , NCH = SEQ / TCH  ;
constexpr int KX = TCH * SC + 2 * SN;
constexpr float LOG2E = 1.4426950408889634f;
constexpr float QSCALE = 0.125f * LOG2E;
constexpr float EPS = 1e-6f;
constexpr int NWAVES = 8, NTHR = 512;

constexpr size_t MiB = 1u << 20;
constexpr size_t WS_MOD = 1 * MiB;
constexpr size_t WS_KS = 2 * MiB;
constexpr size_t WS_ATC = 3 * MiB;
constexpr size_t WS_WIN = 4 * MiB;
constexpr size_t WS_WPA = 12 * MiB;
constexpr size_t WS_WPS = 13 * MiB;
constexpr size_t WS_WGLU = 13 * MiB + 512 * 1024;
constexpr size_t WS_WOUT = 14 * MiB;
constexpr size_t WS_WUP = 16 * MiB;
constexpr size_t WS_WDN = 24 * MiB;
constexpr size_t WS_WST = 28 * MiB;
constexpr size_t WS_KW = 36 * MiB;
constexpr size_t WS_SLOC = 72 * MiB;
constexpr size_t WS_LSE = 80 * MiB;
constexpr size_t WS_MODE = 3 * MiB + 65536;
constexpr size_t WS_PW = 88 * MiB;
constexpr size_t WS_SLOC4 = 96 * MiB;
constexpr size_t WS_XN = 96 * MiB;
constexpr size_t WS_QKV = 708 * MiB;
constexpr size_t WS_OATT = 224 * MiB;
constexpr size_t WS_Y2 = 320 * MiB;
constexpr size_t WS_YG = 320 * MiB;
constexpr size_t WS_GATES = 416 * MiB;
constexpr size_t WS_UX = 672 * MiB;
constexpr size_t WS_OP = 708 * MiB;
constexpr size_t WS_HB = 544 * MiB;
constexpr size_t WS_SSQ = 72 * MiB;
constexpr size_t WS_SHW = 90 * MiB;
constexpr size_t WS_HBF = 708 * MiB;
constexpr size_t WS_XCH = 91 * MiB;
constexpr size_t WS_CNT = 4096;
constexpr size_t WS_UP = 224 * MiB;
constexpr size_t WS_END = 900 * MiB;

__device__ __forceinline__ unsigned cvt_pk_bf16(float lo, float hi) { unsigned r; asm volatile("v_cvt_pk_bf16_f32 %0, %1, %2" : "=v"(r) : "v"(lo), "v"(hi)); return r; }
__device__ __forceinline__ float bf_lo(unsigned w) { return __builtin_bit_cast(float, w << 16); }
__device__ __forceinline__ float bf_hi(unsigned w) { return __builtin_bit_cast(float, w & 0xffff0000u); }
__device__ __forceinline__ float sigmoidf_(float x) { return __builtin_amdgcn_rcpf(1.f + __builtin_amdgcn_exp2f(-x * LOG2E)); }
__device__ __forceinline__ u32x4 pack8(const float* v) { u32x4 w; w.x = cvt_pk_bf16(v[0], v[1]); w.y = cvt_pk_bf16(v[2], v[3]); w.z = cvt_pk_bf16(v[4], v[5]); w.w = cvt_pk_bf16(v[6], v[7]); return w; }
__device__ __forceinline__ void unpack8(u32x4 w, float* v) { v[0] = bf_lo(w.x); v[1] = bf_hi(w.x); v[2] = bf_lo(w.y); v[3] = bf_hi(w.y); v[4] = bf_lo(w.z); v[5] = bf_hi(w.z); v[6] = bf_lo(w.w); v[7] = bf_hi(w.w); }
__device__ __forceinline__ float wave_sum(float v) {
#pragma unroll
    for (int o = 1; o < 64; o <<= 1) v += __shfl_xor(v, o);
    return v;
}

namespace pg8 {
constexpr int BM = 256, BK = 64, HALF = 128, HTB = HALF * BK * 2, STAGE_BYTES = 8 * HTB, NXCD = 8, WGM = 8;
__host__ __device__ __forceinline__ int lds_byte(int r, int c) { const int st = (r >> 4) * 2 + (c >> 5), rr = r & 15, cc = c & 31, ob = rr * 64 + cc * 2; return st * 1024 + (ob ^ (((ob >> 9) & 1) << 5)); }
__host__ __device__ __forceinline__ void stage_rc(int b, int& R, int& C) { const int st = b / 1024, sb = b % 1024, swz = sb ^ (((sb >> 9) & 1) << 5); R = (st >> 1) * 16 + swz / 64; C = (st & 1) * 32 + (swz % 64) / 2; }
__host__ __device__ __forceinline__ int perm32(int rho) { const int n = rho >> 4, i = rho & 15; return 8 * (i >> 2) + 4 * n + (i & 3); }

struct Unit { int pm, pn; };
struct Gemm { const bf16_t* A; const bf16_t* Bt; int lda, ldb, K; };

struct StaticOrder {
    int nM, nN, nwg, G, c;
    __device__ void init(int M_, int N_, int G_, int c_) { nM = M_ / BM; nN = N_ / BM; nwg = nM * nN; G = G_; c = c_; }
    __device__ bool next(int i, Unit& u) const {
        const long L = (long)i * G + c; if (L >= nwg) return false;
        int wgid = (int)L; { const int q = nwg / NXCD, r = nwg % NXCD, xcd = wgid % NXCD, off = wgid / NXCD; wgid = (xcd < r ? xcd * (q + 1) : r * (q + 1) + (xcd - r) * q) + off; }
        const int nig = WGM * nN, gid = wgid / nig, fm = gid * WGM, gsz = (nM - fm) < WGM ? (nM - fm) : WGM;
        u.pm = fm + ((wgid % nig) % gsz); u.pn = (wgid % nig) / gsz; return true;
    }
};
struct SchedS1 { int c; __device__ bool next(int i, Unit& u) const { if (i > 0) return false; const int L = c >> 2; u.pm = L; u.pn = L >> 2; return true; } };
struct SchedS3 { int G, c; __device__ bool next(int i, Unit& u) const { const int L = i * G + c; if (L >= 256) return false; const int g = L >> 4; u.pm = g * 4 + ((L >> 2) & 3); u.pn = g * 4 + (L & 3); return true; } };

#define EPI_BEGIN \
    _Pragma("unroll") for (int ai = 0; ai < 2; ++ai) _Pragma("unroll") for (int m = 0; m < 4; ++m) { const int row = u.pm * 256 + ai * 128 + wr * 64 + m * 16 + fr; \
    _Pragma("unroll") for (int bj = 0; bj < 2; ++bj) { const int col = u.pn * 256 + bj * 128 + wc * 32 + 8 * fq; \
        float v[8]; { const f32x4 v0 = acc[ai][bj][m][0], v1 = acc[ai][bj][m][1]; v[0] = v0[0]; v[1] = v0[1]; v[2] = v0[2]; v[3] = v0[3]; v[4] = v1[0]; v[5] = v1[1]; v[6] = v1[2]; v[7] = v1[3]; }
#define EPI_END } }
#define EPI_ARGS const f32x4 (&acc)[2][2][4][2], const Unit& u, int wr, int wc, int fr, int fq

struct EpiInProj {
    bf16_t* QKV; bf16_t* UX; bf16_t* GATES; const float* b_gate;
    __device__ __forceinline__ void operator()(EPI_ARGS) const {
        const int pn = u.pn;
        if (pn < 6) { const float sc = pn < 2 ? QSCALE : 1.f;
            EPI_BEGIN
#pragma unroll
                for (int j = 0; j < 8; ++j) v[j] *= sc;
                { const int which = col >> 9, hh = (col >> 6) & 7, e0 = col & 63;
                  *(u32x4*)(QKV + (size_t)which * ((size_t)M * 512) + ((size_t)((row >> 11) * 8 + hh) * SEQ + (row & 2047)) * 64 + e0) = pack8(v); }
            EPI_END
        } else if (pn == 6) {
            EPI_BEGIN
                const int lc = col - 1536, g = lc >> 4, c8 = lc & 15, b = row >> 11, t = row & 2047;
                *(u32x4*)(UX + (size_t)(g * 1024 + b * NCH + (t >> 6)) * KX + (t & 63) * 16 + c8) = pack8(v);
            EPI_END
        } else {
            EPI_BEGIN
                const int gc = col - 1792; const f32x4 b0 = *(const f32x4*)(b_gate + gc), b1 = *(const f32x4*)(b_gate + gc + 4);
                v[0] = sigmoidf_(v[0] + b0[0]); v[1] = sigmoidf_(v[1] + b0[1]); v[2] = sigmoidf_(v[2] + b0[2]); v[3] = sigmoidf_(v[3] + b0[3]);
                v[4] = sigmoidf_(v[4] + b1[0]); v[5] = sigmoidf_(v[5] + b1[1]); v[6] = sigmoidf_(v[6] + b1[2]); v[7] = sigmoidf_(v[7] + b1[3]);
                *(u32x4*)(GATES + (size_t)row * 2048 + gc) = pack8(v);
            EPI_END
        }
    }
};
struct EpiS1 {
    float* SLOC;
    __device__ __forceinline__ void operator()(EPI_ARGS) const {
        EPI_BEGIN
            if (bj == 0) { const int lc = col & 255; float* d = SLOC + (size_t)row * 128 + lc; *(f32x4*)d = (f32x4){v[0], v[1], v[2], v[3]}; *(f32x4*)(d + 4) = (f32x4){v[4], v[5], v[6], v[7]}; }
        EPI_END
    }
};
struct EpiS3 {
    const bf16_t* UX; const float* d_skip; bf16_t* Y2;
    __device__ __forceinline__ void operator()(EPI_ARGS) const {
        EPI_BEGIN
            const int g = row >> 10, bc = row & 1023, lc = col & 1023, i = lc >> 4, c8 = lc & 15;
            float uu[8]; unpack8(*(const u32x4*)(UX + (size_t)row * KX + lc), uu);
            const f32x4 d0 = *(const f32x4*)(d_skip + g * 16 + c8), d1 = *(const f32x4*)(d_skip + g * 16 + c8 + 4);
            const float dd[8] = {d0[0], d0[1], d0[2], d0[3], d1[0], d1[1], d1[2], d1[3]};
#pragma unroll
            for (int j = 0; j < 8; ++j) { const float y = v[j] + dd[j] * uu[j]; v[j] = y * sigmoidf_(1.5957691216057308f * (y + 0.044715f * y * y * y)); }
            *(u32x4*)(Y2 + (size_t)(bc * 64 + i) * 256 + g * 16 + c8) = pack8(v);
        EPI_END
    }
};
struct EpiGlu {
    const bf16_t* Y2; const float* b_glu; bf16_t* YG;
    __device__ __forceinline__ void operator()(EPI_ARGS) const {
        EPI_BEGIN
            float y[8]; unpack8(*(const u32x4*)(Y2 + (size_t)row * 256 + col), y);
            const f32x4 b0 = *(const f32x4*)(b_glu + col), b1 = *(const f32x4*)(b_glu + col + 4);
            const float bb[8] = {b0[0], b0[1], b0[2], b0[3], b1[0], b1[1], b1[2], b1[3]};
#pragma unroll
            for (int j = 0; j < 8; ++j) v[j] = y[j] * sigmoidf_(v[j] + bb[j]);
            *(u32x4*)(YG + (size_t)row * 768 + 512 + col) = pack8(v);
        EPI_END
    }
};
struct EpiMerge1 {
    const bf16_t* GATES; bf16_t* MG;
    __device__ __forceinline__ void mid(f32x4 (&acc)[2][2][4][2], const Unit& u, int wr, int wc, int fr, int fq) const {
        int pm_ = u.pm; asm volatile("" : "+s"(pm_));
        const bf16_t* gbase = GATES + (size_t)(pm_ * 256 + wr * 64 + fr) * 2048 + u.pn * 256 + wc * 32 + 8 * fq;
#pragma unroll
        for (int ai = 0; ai < 2; ++ai)
#pragma unroll
            for (int m = 0; m < 4; ++m) {
#pragma unroll
                for (int bj = 0; bj < 2; ++bj) { const bf16_t* gp = gbase + (size_t)(ai * 128 + m * 16) * 2048 + bj * 128;
                    float sa[8], ss[8]; unpack8(__builtin_nontemporal_load((const u32x4*)gp), sa); unpack8(*(const u32x4*)(gp + 1024), ss);
                    f32x4 r0, r1;
                    r0[0] = sa[0] * __builtin_amdgcn_rcpf(ss[0]); r0[1] = sa[1] * __builtin_amdgcn_rcpf(ss[1]); r0[2] = sa[2] * __builtin_amdgcn_rcpf(ss[2]); r0[3] = sa[3] * __builtin_amdgcn_rcpf(ss[3]);
                    r1[0] = sa[4] * __builtin_amdgcn_rcpf(ss[4]); r1[1] = sa[5] * __builtin_amdgcn_rcpf(ss[5]); r1[2] = sa[6] * __builtin_amdgcn_rcpf(ss[6]); r1[3] = sa[7] * __builtin_amdgcn_rcpf(ss[7]);
                    acc[ai][bj][m][0] = acc[ai][bj][m][0] * r0; acc[ai][bj][m][1] = acc[ai][bj][m][1] * r1; }
                __builtin_amdgcn_sched_barrier(0); }
    }
    __device__ __forceinline__ void operator()(EPI_ARGS) const {
        EPI_BEGIN
            float ss[8]; unpack8(__builtin_nontemporal_load((const u32x4*)(GATES + (size_t)row * 2048 + 1024 + col)), ss);
#pragma unroll
            for (int j = 0; j < 8; ++j) v[j] *= ss[j];
            *(u32x4*)(MG + (size_t)row * 1024 + col) = pack8(v);
        EPI_END
    }
};
template <int PASS> struct EpiMerge {
    const bf16_t* GATES; bf16_t* MG;
    __device__ __forceinline__ void operator()(EPI_ARGS) const {
        EPI_BEGIN
            float s[8]; unpack8(*(const u32x4*)(GATES + (size_t)row * 2048 + PASS * 1024 + col), s);
            bf16_t* d = MG + (size_t)row * 1024 + col;
            if (PASS == 1) { float o[8]; unpack8(*(const u32x4*)d, o);
#pragma unroll
                for (int j = 0; j < 8; ++j) v[j] = o[j] + s[j] * v[j];
            } else {
#pragma unroll
                for (int j = 0; j < 8; ++j) v[j] = s[j] * v[j];
            }
            *(u32x4*)d = pack8(v);
        EPI_END
    }
};
struct EpiRes {
    const float* base; const float* gate  ; float* out;
    __device__ __forceinline__ void operator()(EPI_ARGS) const {
        EPI_BEGIN
            const int b = row >> 11; const float* gp = gate + b * 6144 + col; const float* bp = base + (size_t)row * 1024 + col; float* op = out + (size_t)row * 1024 + col;
            const f32x4 g0 = *(const f32x4*)gp, g1 = *(const f32x4*)(gp + 4), x0 = *(const f32x4*)bp, x1 = *(const f32x4*)(bp + 4);
            *(f32x4*)op = (f32x4){x0[0] + g0[0] * v[0], x0[1] + g0[1] * v[1], x0[2] + g0[2] * v[2], x0[3] + g0[3] * v[3]};
            *(f32x4*)(op + 4) = (f32x4){x1[0] + g1[0] * v[4], x1[1] + g1[1] * v[5], x1[2] + g1[2] * v[6], x1[3] + g1[3] * v[7]};
        EPI_END
    }
};
struct SchedChain { int c; __device__ bool next(int i, Unit& u) const { if (i >= 16) return false; const int xx = c & 7, k = c >> 3, round = i >> 3, step = i & 7; u.pm = 8 * (4 * xx + (k >> 3)) + step; u.pn = (k & 7) + 8 * round; return true; } };
__device__ __forceinline__ float dpp_ror1(float v) { return __builtin_bit_cast(float, __builtin_amdgcn_update_dpp(__builtin_bit_cast(int, v), __builtin_bit_cast(int, v), 0x121, 0xf, 0xf, false)); }
__device__ __forceinline__ float dpp_ror2(float v) { return __builtin_bit_cast(float, __builtin_amdgcn_update_dpp(__builtin_bit_cast(int, v), __builtin_bit_cast(int, v), 0x122, 0xf, 0xf, false)); }
struct EpiUpConv {
    bf16_t* ACT; const float* w_conv; const float* b_conv; LAS float* xb;
    const float* SSQp; const float* SHWp;
    __device__ __forceinline__ void operator()(f32x4 (&acc)[2][2][4][2], const Unit& u, int wr, int wc, int fr, int fq) const {
        const int colb = wc * 32 + 8 * fq, step = u.pm & 7, par = step & 1;
        { const float* sp = SHWp + (u.pm >> 3) * 4096 + u.pn * 256 + colb; const f32x4 sa0 = *(const f32x4*)sp, sa1 = *(const f32x4*)(sp + 4), sv0 = *(const f32x4*)(sp + 128), sv1 = *(const f32x4*)(sp + 132);
#pragma unroll
          for (int ai = 0; ai < 2; ++ai)
#pragma unroll
              for (int m = 0; m < 4; ++m) { const int row = u.pm * 256 + ai * 128 + wr * 64 + m * 16 + fr; const f32x4 q0 = *(const f32x4*)(SSQp + (size_t)row * 16 + 4 * fq);
                  float tot = (q0[0] + q0[1]) + (q0[2] + q0[3]); tot += __shfl_xor(tot, 16); tot += __shfl_xor(tot, 32);
                  const float rstd = 1.f / sqrtf(tot * (1.f / DM) + EPS);
                  acc[ai][0][m][0] = acc[ai][0][m][0] * rstd + sa0; acc[ai][0][m][1] = acc[ai][0][m][1] * rstd + sa1;
                  acc[ai][1][m][0] = acc[ai][1][m][0] * rstd + sv0; acc[ai][1][m][1] = acc[ai][1][m][1] * rstd + sv1; } }
#pragma unroll
        for (int ai = 0; ai < 2; ++ai) { const int slot = (ai == 0) ? wr : (wr == 0 ? 2 : 4 + par);
            if (fr >= 14) { LAS float* d = xb + (slot * 2 + (fr - 14)) * 128 + colb; *(LAS f32x4*)d = acc[ai][0][3][0]; *(LAS f32x4*)(d + 4) = acc[ai][0][3][1]; } }
        asm volatile("s_waitcnt lgkmcnt(0)" ::: "memory"); __builtin_amdgcn_s_barrier(); asm volatile("" ::: "memory");
        float w0[8], w1[8], w2[8], bc[8];
        { const int j0 = u.pn * 128 + colb;
#pragma unroll
          for (int j = 0; j < 8; ++j) { w0[j] = w_conv[j0 + j]; w1[j] = w_conv[FF + j0 + j]; w2[j] = w_conv[2 * FF + j0 + j]; bc[j] = b_conv[j0 + j]; } }
#pragma unroll
        for (int ai = 0; ai < 2; ++ai) {
            float prev[8];
            { const int src = (ai == 0) ? (wr == 0 ? 4 + (par ^ 1) : 0) : (wr == 0 ? 1 : 2); const bool zero = (ai == 0) && (wr == 0) && (step == 0);
              const LAS float* p = xb + (src * 2 + (fr & 1)) * 128 + colb; const f32x4 p0 = *(const LAS f32x4*)p, p1 = *(const LAS f32x4*)(p + 4);
              prev[0] = zero ? 0.f : p0[0]; prev[1] = zero ? 0.f : p0[1]; prev[2] = zero ? 0.f : p0[2]; prev[3] = zero ? 0.f : p0[3];
              prev[4] = zero ? 0.f : p1[0]; prev[5] = zero ? 0.f : p1[1]; prev[6] = zero ? 0.f : p1[2]; prev[7] = zero ? 0.f : p1[3]; }
#pragma unroll
            for (int m = 0; m < 4; ++m) { const int row = u.pm * 256 + ai * 128 + wr * 64 + m * 16 + fr;
                float cur[8], vv[8], o[8];
                { const f32x4 a0 = acc[ai][0][m][0], a1 = acc[ai][0][m][1], v0 = acc[ai][1][m][0], v1 = acc[ai][1][m][1];
                  cur[0] = a0[0]; cur[1] = a0[1]; cur[2] = a0[2]; cur[3] = a0[3]; cur[4] = a1[0]; cur[5] = a1[1]; cur[6] = a1[2]; cur[7] = a1[3];
                  vv[0] = v0[0]; vv[1] = v0[1]; vv[2] = v0[2]; vv[3] = v0[3]; vv[4] = v1[0]; vv[5] = v1[1]; vv[6] = v1[2]; vv[7] = v1[3]; }
#pragma unroll
                for (int j = 0; j < 8; ++j) { const float r1 = dpp_ror1(cur[j]), q1 = dpp_ror1(prev[j]), r2 = dpp_ror2(cur[j]), q2 = dpp_ror2(prev[j]);
                    const float a1 = (fr == 0) ? q1 : r1, a2 = (fr < 2) ? q2 : r2;
                    const float cv = bc[j] + w0[j] * cur[j] + w1[j] * a1 + w2[j] * a2; o[j] = cv * sigmoidf_(cv) * vv[j]; prev[j] = cur[j]; }
                *(u32x4*)(ACT + (size_t)row * FF + u.pn * 128 + colb) = pack8(o); }
        }
    }
};
struct EpiResNorm {
    const float* base; const float* MODp; const float* g_ffn; bf16_t* Hbf; bf16_t* HBp; float* SSQp;
    __device__ __forceinline__ void operator()(EPI_ARGS) const {
#pragma unroll
        for (int ai = 0; ai < 2; ++ai)
#pragma unroll
            for (int m = 0; m < 4; ++m) { const int row = u.pm * 256 + ai * 128 + wr * 64 + m * 16 + fr, b = row >> 11; float ss = 0.f;
#pragma unroll
                for (int bj = 0; bj < 2; ++bj) { const int col = u.pn * 256 + bj * 128 + wc * 32 + 8 * fq;
                    const f32x4 v0 = acc[ai][bj][m][0], v1 = acc[ai][bj][m][1];
                    const float* mp = MODp + b * 6144 + col; const float* bp = base + (size_t)row * 1024 + col;
                    const f32x4 g0 = *(const f32x4*)(mp + 2048), g1 = *(const f32x4*)(mp + 2048 + 4), x0 = __builtin_nontemporal_load((const f32x4*)bp), x1 = __builtin_nontemporal_load((const f32x4*)(bp + 4));
                    const f32x4 s0 = *(const f32x4*)(mp + 4096), s1 = *(const f32x4*)(mp + 4096 + 4), f0 = *(const f32x4*)(g_ffn + col), f1 = *(const f32x4*)(g_ffn + col + 4);
                    float h[8] = {x0[0] + g0[0] * v0[0], x0[1] + g0[1] * v0[1], x0[2] + g0[2] * v0[2], x0[3] + g0[3] * v0[3], x1[0] + g1[0] * v1[0], x1[1] + g1[1] * v1[1], x1[2] + g1[2] * v1[2], x1[3] + g1[3] * v1[3]};
                    *(u32x4*)(Hbf + (size_t)row * 1024 + col) = pack8(h);
#pragma unroll
                    for (int j = 0; j < 8; ++j) ss += h[j] * h[j];
                    const float gmv[8] = {f0[0] * (1.f + s0[0]), f0[1] * (1.f + s0[1]), f0[2] * (1.f + s0[2]), f0[3] * (1.f + s0[3]), f1[0] * (1.f + s1[0]), f1[1] * (1.f + s1[1]), f1[2] * (1.f + s1[2]), f1[3] * (1.f + s1[3])};
#pragma unroll
                    for (int j = 0; j < 8; ++j) h[j] *= gmv[j];
                    *(u32x4*)(HBp + (size_t)row * 1024 + col) = pack8(h); }
                ss += __shfl_xor(ss, 16); ss += __shfl_xor(ss, 32);
                if (fq == 0) SSQp[(size_t)row * 16 + u.pn * 4 + wc] = ss; }
    }
};
struct EpiRes2 {
    const bf16_t* base; const float* gate  ; bf16_t* H2; float* SSQp;
    __device__ __forceinline__ void operator()(EPI_ARGS) const {
#pragma unroll
        for (int ai = 0; ai < 2; ++ai)
#pragma unroll
            for (int m = 0; m < 4; ++m) { const int row = u.pm * 256 + ai * 128 + wr * 64 + m * 16 + fr, b = row >> 11; float ss = 0.f;
#pragma unroll
                for (int bj = 0; bj < 2; ++bj) { const int col = u.pn * 256 + bj * 128 + wc * 32 + 8 * fq;
                    const f32x4 v0 = acc[ai][bj][m][0], v1 = acc[ai][bj][m][1];
                    const float* gp = gate + b * 6144 + col; float xb[8]; unpack8(*(const u32x4*)(base + (size_t)row * 1024 + col), xb);
                    const f32x4 g0 = *(const f32x4*)gp, g1 = *(const f32x4*)(gp + 4);
                    float h[8] = {xb[0] + g0[0] * v0[0], xb[1] + g0[1] * v0[1], xb[2] + g0[2] * v0[2], xb[3] + g0[3] * v0[3], xb[4] + g1[0] * v1[0], xb[5] + g1[1] * v1[1], xb[6] + g1[2] * v1[2], xb[7] + g1[3] * v1[3]};
#pragma unroll
                    for (int j = 0; j < 8; ++j) ss += h[j] * h[j];
                    *(u32x4*)(H2 + (size_t)row * 1024 + col) = pack8(h); }
                ss += __shfl_xor(ss, 16); ss += __shfl_xor(ss, 32);
                if (fq == 0) SSQp[(size_t)row * 16 + u.pn * 4 + wc] = ss; }
    }
};
struct EpiResFinal {
    const bf16_t* base; const float* gate  ; const float* g_final; float* out; float* XCH; unsigned* CNT; LAS float* misc;
    __device__ __forceinline__ void operator()(f32x4 (&acc)[2][2][4][2], const Unit& u, int wr, int wc, int fr, int fq) const {
        const int tid = (wr * 4 + wc) * 64 + fq * 16 + fr;
        LAS float* part = misc; LAS float* rs = misc + 1024;
#pragma unroll
        for (int ai = 0; ai < 2; ++ai)
#pragma unroll
            for (int m = 0; m < 4; ++m) { const int rl = ai * 128 + wr * 64 + m * 16 + fr, row = u.pm * 256 + rl, b = row >> 11; float ss = 0.f;
#pragma unroll
                for (int bj = 0; bj < 2; ++bj) { const int col = u.pn * 256 + bj * 128 + wc * 32 + 8 * fq;
                    const float* gp = gate + b * 6144 + col; float xb[8]; unpack8(__builtin_nontemporal_load((const u32x4*)(base + (size_t)row * 1024 + col)), xb);
                    const f32x4 g0 = *(const f32x4*)gp, g1 = *(const f32x4*)(gp + 4); f32x4 h0, h1;
                    h0[0] = xb[0] + g0[0] * acc[ai][bj][m][0][0]; h0[1] = xb[1] + g0[1] * acc[ai][bj][m][0][1]; h0[2] = xb[2] + g0[2] * acc[ai][bj][m][0][2]; h0[3] = xb[3] + g0[3] * acc[ai][bj][m][0][3];
                    h1[0] = xb[4] + g1[0] * acc[ai][bj][m][1][0]; h1[1] = xb[5] + g1[1] * acc[ai][bj][m][1][1]; h1[2] = xb[6] + g1[2] * acc[ai][bj][m][1][2]; h1[3] = xb[7] + g1[3] * acc[ai][bj][m][1][3];
                    ss += (h0[0] * h0[0] + h0[1] * h0[1]) + (h0[2] * h0[2] + h0[3] * h0[3]) + (h1[0] * h1[0] + h1[1] * h1[1]) + (h1[2] * h1[2] + h1[3] * h1[3]);
                    acc[ai][bj][m][0] = h0; acc[ai][bj][m][1] = h1; }
                ss += __shfl_xor(ss, 16); ss += __shfl_xor(ss, 32);
                if (fq == 0) part[wc * 256 + rl] = ss; }
        asm volatile("s_waitcnt lgkmcnt(0)" ::: "memory"); __builtin_amdgcn_s_barrier(); asm volatile("" ::: "memory");
        if (tid < 256) { const float tot = (part[tid] + part[256 + tid]) + (part[512 + tid] + part[768 + tid]);
            __hip_atomic_store(XCH + (size_t)(u.pm * 4 + u.pn) * 256 + tid, tot, __ATOMIC_RELAXED, __HIP_MEMORY_SCOPE_AGENT); }
        asm volatile("s_waitcnt vmcnt(0)" ::: "memory"); __builtin_amdgcn_s_barrier(); asm volatile("" ::: "memory");
        if (tid == 0) { __hip_atomic_fetch_add(CNT + u.pm, 1u, __ATOMIC_RELAXED, __HIP_MEMORY_SCOPE_AGENT);
            while (__hip_atomic_load(CNT + u.pm, __ATOMIC_RELAXED, __HIP_MEMORY_SCOPE_AGENT) < 4u) __builtin_amdgcn_s_sleep(1); }
        asm volatile("s_waitcnt vmcnt(0)" ::: "memory"); __builtin_amdgcn_s_barrier(); asm volatile("" ::: "memory");
        if (tid < 256) { const float* xp = XCH + (size_t)(u.pm * 4) * 256 + tid;
            const float t0 = __hip_atomic_load(xp, __ATOMIC_RELAXED, __HIP_MEMORY_SCOPE_AGENT), t1 = __hip_atomic_load(xp + 256, __ATOMIC_RELAXED, __HIP_MEMORY_SCOPE_AGENT),
                        t2 = __hip_atomic_load(xp + 512, __ATOMIC_RELAXED, __HIP_MEMORY_SCOPE_AGENT), t3 = __hip_atomic_load(xp + 768, __ATOMIC_RELAXED, __HIP_MEMORY_SCOPE_AGENT);
            rs[tid] = 1.f / sqrtf(((t0 + t1) + (t2 + t3)) * (1.f / DM) + EPS); }
        asm volatile("s_waitcnt lgkmcnt(0)" ::: "memory"); __builtin_amdgcn_s_barrier(); asm volatile("" ::: "memory");
#pragma unroll
        for (int ai = 0; ai < 2; ++ai)
#pragma unroll
            for (int m = 0; m < 4; ++m) { const int rl = ai * 128 + wr * 64 + m * 16 + fr, row = u.pm * 256 + rl; const float r = rs[rl];
#pragma unroll
                for (int bj = 0; bj < 2; ++bj) { const int col = u.pn * 256 + bj * 128 + wc * 32 + 8 * fq; float* op = out + (size_t)row * 1024 + col;
                    const f32x4 f0 = *(const f32x4*)(g_final + col), f1 = *(const f32x4*)(g_final + col + 4);
                    *(f32x4*)op = acc[ai][bj][m][0] * r * f0; *(f32x4*)(op + 4) = acc[ai][bj][m][1] * r * f1; } }
    }
};
struct EpiUp {
    bf16_t* UP;
    __device__ __forceinline__ void operator()(EPI_ARGS) const {
        EPI_BEGIN
            *(u32x4*)(UP + (size_t)row * 4096 + col) = pack8(v);
        EPI_END
    }
};

template <class Epi, class Sched, int MID_T = -1>
__device__ __forceinline__ void gemm_phase(LAS unsigned char* lds, const Gemm g, const Sched& S, const Epi& E, const int wid, const int lane) {
    const int tid = wid * 64 + lane, wr = wid >> 2, wc = wid & 3, fr = lane & 15, fq = lane >> 4;
    const int K = g.K, nt = K / BK;
    unsigned voffA[2], voffB[2];
#pragma unroll
    for (int i = 0; i < 2; ++i) { int R, C; stage_rc(tid * 16 + i * 8192, R, C); const int Rb = (R & ~31) + perm32(R & 31);
        voffA[i] = (unsigned)(R * g.lda + C) * 2u; voffB[i] = (unsigned)(Rb * g.ldb + C) * 2u; }
    const size_t kstep = (size_t)(BK * 2);
    const size_t hA = (size_t)HALF * g.lda * 2, hB = (size_t)HALF * g.ldb * 2, tA = 2 * hA, tB = 2 * hB;
    const unsigned ldsw = (unsigned)wid * 1024u;
    const int aoff = lds_byte(wr * 64 + fr, fq * 8), boff = lds_byte(wc * 32 + fr, fq * 8);
#define PG8_SA(b, h) (((b) * 2 + (h)) * HTB)
#define PG8_SB(b, h) ((4 + (b) * 2 + (h)) * HTB)
#define PG8_STAGE(bufoff, gbase, voff) do { _Pragma("unroll") for (int _i = 0; _i < 2; ++_i) \
        __builtin_amdgcn_global_load_lds((const GAS unsigned*)((const char*)(gbase) + (voff)[_i]), (LAS unsigned*)(lds + (bufoff) + ldsw + _i * 8192), 16, 0, 0); } while (0)
#define PG8_LDA(dst, b, h) do { _Pragma("unroll") for (int m = 0; m < 4; ++m) _Pragma("unroll") for (int k = 0; k < 2; ++k) dst[m][k] = *(const LAS bf16x8*)(lds + PG8_SA(b, h) + aoff + m * 2048 + k * 1024); } while (0)
#define PG8_LDB(dst, b, h) do { _Pragma("unroll") for (int n = 0; n < 2; ++n) _Pragma("unroll") for (int k = 0; k < 2; ++k) dst[n][k] = *(const LAS bf16x8*)(lds + PG8_SB(b, h) + boff + n * 2048 + k * 1024); } while (0)
#define PG8_MMA(ai, bj, At, Bt) do { __builtin_amdgcn_s_setprio(1); _Pragma("unroll") for (int m = 0; m < 4; ++m) _Pragma("unroll") for (int n = 0; n < 2; ++n) _Pragma("unroll") for (int k = 0; k < 2; ++k) \
        acc[ai][bj][m][n] = __builtin_amdgcn_mfma_f32_16x16x32_bf16(Bt[n][k], At[m][k], acc[ai][bj][m][n], 0, 0, 0); __builtin_amdgcn_s_setprio(0); } while (0)
#define PG8_WAIT_V(n) asm volatile("s_waitcnt vmcnt(" #n ")" ::: "memory")
#define PG8_WAIT_L(n) asm volatile("s_waitcnt lgkmcnt(" #n ")" ::: "memory")
#define PG8_BAR __builtin_amdgcn_s_barrier()
#define PG8_SCHED __builtin_amdgcn_sched_barrier(0)
    Unit cur, nxt; int ui = 0;
    if (!S.next(0, cur)) return;
    f32x4 acc[2][2][4][2];
#pragma unroll
    for (int a = 0; a < 2; ++a)
#pragma unroll
        for (int b = 0; b < 2; ++b)
#pragma unroll
            for (int m = 0; m < 4; ++m)
#pragma unroll
                for (int n = 0; n < 2; ++n) acc[a][b][m][n] = (f32x4){0.f, 0.f, 0.f, 0.f};
    bf16x8 At[4][2], B0[2][2], B1[2][2];
    const char* cA = (const char*)g.A + (size_t)cur.pm * tA; const char* cB = (const char*)g.Bt + (size_t)cur.pn * tB;
    PG8_STAGE(PG8_SB(0, 0), cB, voffB); PG8_STAGE(PG8_SB(0, 1), cB + hB, voffB); PG8_STAGE(PG8_SA(0, 0), cA, voffA); PG8_STAGE(PG8_SA(0, 1), cA + hA, voffA);
    if (wr == 1) PG8_BAR;
    PG8_WAIT_V(2); PG8_BAR;
    PG8_STAGE(PG8_SB(1, 0), cB + kstep, voffB); PG8_STAGE(PG8_SA(1, 0), cA + kstep, voffA); PG8_STAGE(PG8_SB(1, 1), cB + hB + kstep, voffB);
    PG8_WAIT_V(6); PG8_BAR;
    for (;;) {
        const bool has_next = S.next(ui + 1, nxt);
        const char* nA = has_next ? (const char*)g.A + (size_t)nxt.pm * tA : cA; const char* nB = has_next ? (const char*)g.Bt + (size_t)nxt.pn * tB : cB;
        for (int t = 0; t < nt; t += 2) {
            const bool last = (t == nt - 2);
            if constexpr (MID_T >= 0) { if (t == MID_T) E.mid(acc, cur, wr, wc, fr, fq); }
            const char* a1 = cA + (size_t)(t + 1) * kstep;
            const char* a2 = last ? nA : cA + (size_t)(t + 2) * kstep; const char* b2 = last ? nB : cB + (size_t)(t + 2) * kstep;
            const char* a3 = a2 + kstep; const char* b3 = b2 + kstep;
            PG8_LDB(B0, 0, 0); PG8_LDB(B1, 0, 1); PG8_SCHED; PG8_LDA(At, 0, 0); PG8_STAGE(PG8_SA(1, 1), a1 + hA, voffA);
            PG8_WAIT_V(8); PG8_WAIT_L(0); PG8_BAR; PG8_MMA(0, 0, At, B0); PG8_MMA(0, 1, At, B1); PG8_BAR; PG8_SCHED;
            PG8_LDA(At, 0, 1); PG8_STAGE(PG8_SB(0, 0), b2, voffB); PG8_STAGE(PG8_SB(0, 1), b2 + hB, voffB); PG8_STAGE(PG8_SA(0, 0), a2, voffA);
            PG8_WAIT_V(8); PG8_WAIT_L(0); PG8_BAR; PG8_MMA(1, 0, At, B0); PG8_MMA(1, 1, At, B1); PG8_BAR; PG8_SCHED;
            PG8_LDB(B0, 1, 0); PG8_LDB(B1, 1, 1); PG8_SCHED; PG8_LDA(At, 1, 0); PG8_STAGE(PG8_SA(0, 1), a2 + hA, voffA);
            PG8_WAIT_V(8); PG8_WAIT_L(0); PG8_BAR; PG8_MMA(0, 0, At, B0); PG8_MMA(0, 1, At, B1); PG8_BAR; PG8_SCHED;
            PG8_LDA(At, 1, 1); PG8_STAGE(PG8_SB(1, 0), b3, voffB); PG8_STAGE(PG8_SB(1, 1), b3 + hB, voffB); PG8_STAGE(PG8_SA(1, 0), a3, voffA);
            PG8_WAIT_V(8); PG8_WAIT_L(0); PG8_BAR; PG8_MMA(1, 0, At, B0); PG8_MMA(1, 1, At, B1); PG8_BAR; PG8_SCHED;
        }
        if (wr == 0) PG8_BAR;
        E(acc, cur, wr, wc, fr, fq);
        if (!has_next) break;
#pragma unroll
        for (int a = 0; a < 2; ++a)
#pragma unroll
            for (int b = 0; b < 2; ++b)
#pragma unroll
                for (int m = 0; m < 4; ++m)
#pragma unroll
                    for (int n = 0; n < 2; ++n) acc[a][b][m][n] = (f32x4){0.f, 0.f, 0.f, 0.f};
        cur = nxt; cA = nA; cB = nB; ++ui;
        if (wr == 1) PG8_BAR;
    }
    PG8_WAIT_V(0);
    PG8_BAR;
#undef PG8_SA
#undef PG8_SB
#undef PG8_STAGE
#undef PG8_LDA
#undef PG8_LDB
#undef PG8_MMA
#undef PG8_WAIT_V
#undef PG8_WAIT_L
#undef PG8_BAR
#undef PG8_SCHED
}
}

struct Args { const float* in[26]; float* out; unsigned char* ws; int ph_lo, ph_hi, pad0, pad1; };

__device__ __forceinline__ void transpose_item(const float* W, int K, int N, bf16_t* WT, LAS float* scr, int item, int lane, bool perm_up = false, int ldw = 0, int koff = 0) {
    if (ldw == 0) ldw = K;
    const int nblk = N / 32, kb = item / nblk, nb = item % nblk, k0 = 64 * kb, n0 = 32 * nb;
    float tv[32];
#pragma unroll
    for (int i = 0; i < 32; ++i) tv[i] = W[(size_t)(k0 + 2 * i + (lane >> 5)) * N + n0 + (lane & 31)];
#pragma unroll
    for (int i = 0; i < 32; ++i) scr[(2 * i + (lane >> 5)) * 33 + (lane & 31)] = tv[i];
    asm volatile("s_waitcnt lgkmcnt(0)" ::: "memory");
    const int c = lane & 7;
#pragma unroll
    for (int j = 0; j < 4; ++j) { const int n = (lane >> 3) + 8 * j; const LAS float* s = scr + (8 * c) * 33 + n;
        u32x4 o; o.x = cvt_pk_bf16(s[0 * 33], s[1 * 33]); o.y = cvt_pk_bf16(s[2 * 33], s[3 * 33]); o.z = cvt_pk_bf16(s[4 * 33], s[5 * 33]); o.w = cvt_pk_bf16(s[6 * 33], s[7 * 33]);
        int nn = n0 + n; if (perm_up) nn = (nn < FF) ? ((nn >> 7) * 256 + (nn & 127)) : (((nn - FF) >> 7) * 256 + 128 + ((nn - FF) & 127));
        *(u32x4*)(WT + (size_t)nn * ldw + koff + k0 + 8 * c) = o; }
    asm volatile("s_waitcnt lgkmcnt(0)" ::: "memory");
}

template <bool SILU, bool PERM_UP>
__device__ __forceinline__ void gemv32(LAS unsigned char* lds, const float* IN, int in_pitch, const float* W, int N, int c0, const float* bias, float* OUT, int out_pitch, int tid, int wave, int lane) {
    LAS float* cact = (LAS float*)lds;
    for (int i0 = tid; i0 < NBATCH * DM; i0 += 16 * NTHR) { float t[16];
#pragma unroll
        for (int k = 0; k < 16; ++k) { const int i = i0 + k * NTHR; t[k] = IN[(i >> 10) * in_pitch + (i & 1023)]; }
#pragma unroll
        for (int k = 0; k < 16; ++k) { const int i = i0 + k * NTHR; cact[(i >> 10) * 1025 + (i & 1023)] = SILU ? t[k] * sigmoidf_(t[k]) : t[k]; } }
    __syncthreads();
    typedef float f32x16 __attribute__((ext_vector_type(16)));
    f32x16 macc;
#pragma unroll
    for (int i = 0; i < 16; ++i) macc[i] = 0.f;
    const int kb = wave * 128 + (lane >> 5), cl = lane & 31;
    const float* wp = W + (size_t)kb * N + c0 + cl; const LAS float* cp = cact + cl * 1025 + kb;
    for (int k0 = 0; k0 < 64; k0 += 16) { float wv[16], cv[16];
#pragma unroll
        for (int kk = 0; kk < 16; ++kk) { wv[kk] = wp[(size_t)(k0 + kk) * 2 * N]; cv[kk] = cp[(k0 + kk) * 2]; }
#pragma unroll
        for (int kk = 0; kk < 16; ++kk) macc = __builtin_amdgcn_mfma_f32_32x32x2f32(cv[kk], wv[kk], macc, 0, 0, 0); }
    __syncthreads();
    LAS float* red = (LAS float*)lds;
#pragma unroll
    for (int i = 0; i < 16; ++i) red[(wave * 16 + i) * 64 + lane] = macc[i];
    __syncthreads();
    for (int o = tid; o < 1024; o += NTHR) { float s = 0.f;
#pragma unroll
        for (int w8 = 0; w8 < 8; ++w8) s += red[w8 * 1024 + o];
        const int i = o >> 6, l = o & 63, b = (i & 3) + 8 * (i >> 2) + 4 * (l >> 5), cc = c0 + (l & 31);
        int oc = cc; if (PERM_UP) oc = (cc < FF) ? ((cc >> 7) * 256 + (cc & 127)) : (((cc - FF) >> 7) * 256 + 128 + ((cc - FF) & 127));
        OUT[b * out_pitch + oc] = s + (bias ? bias[cc] : 0.f); }
    __syncthreads();
}

struct cplx { double re, im; };
__device__ __forceinline__ cplx cmul(cplx a, cplx b) { return cplx{a.re * b.re - a.im * b.im, a.re * b.im + a.im * b.re}; }
__device__ __forceinline__ cplx cpow_int(cplx a, int e) { cplx r{1.0, 0.0};
    while (e > 0) { if (e & 1) r = cmul(r, a); a = cmul(a, a); e >>= 1; } return r; }
__device__ __forceinline__ double dexp(double x) {
    const double k = __builtin_rint(x * 1.4426950408889634074); const double r = x - k * 0.693147180559945309417;
    double t = 1.0, s = 1.0;
    for (int i = 1; i <= 22; ++i) { t *= r / (double)i; s += t; }
    const long long bits = ((long long)(1023 + (int)k)) << 52; return s * __builtin_bit_cast(double, bits);
}
__device__ __forceinline__ void dsincos(double x, double& sn, double& cs) {
    const double k = __builtin_rint(x * 0.159154943091895335769); const double r = (x - k * 6.28318530717958623200) - k * 2.4492935982947064e-16;
    const double r2 = r * r; double ts = r, tc = 1.0; sn = r; cs = 1.0;
    for (int i = 1; i <= 16; ++i) { tc *= -r2 / (double)((2 * i - 1) * (2 * i)); cs += tc; ts *= -r2 / (double)((2 * i) * (2 * i + 1)); sn += ts; }
}
struct SsmMode { cplx ab, f; };
__device__ __forceinline__ SsmMode ssm_mode(const float* a_re, const float* a_im, const float* log_dt, int g, int n) {
    const double lr = (double)a_re[g * SN + n], li = (double)a_im[g * SN + n], dt = dexp((double)log_dt[g]);
    const double mag = dexp(lr * dt); double sn, cs; dsincos(li * dt, sn, cs);
    SsmMode mo; mo.ab = cplx{mag * cs, mag * sn};
    const double nr = mo.ab.re - 1.0, ni = mo.ab.im, den = lr * lr + li * li;
    mo.f = cplx{(nr * lr + ni * li) / den, (ni * lr - nr * li) / den};
    return mo;
}

constexpr int AKP = 144, AVP = 160, ASLOT = 128 * (AKP + AVP), ALDS_V = 128 * AKP;
typedef short v4i16_t __attribute__((ext_vector_type(4)));
__device__ __forceinline__ void attn_step_decode(int g, int& p, int& r, int& n) { p = g >> 4; const int q = g & 15; r = q >> (4 - 2 * p); n = q & ((16 >> (2 * p)) - 1); }
__device__ __forceinline__ void attn_load_kv(const bf16_t* QKV, int b, int h, int g, int tid, u32x4 (&kreg)[2], u32x4 (&vreg)[2]) {
    int p, r, n; attn_step_decode(g, p, r, n);
#pragma unroll
    for (int i = 0; i < 2; ++i) { const int cid = tid + 512 * i, row = cid >> 3, cc = cid & 7;
        const bf16_t* src = QKV + ((size_t)(b * 8 + h) * SEQ + ((n * 128 + row) << (2 * p)) + r) * 64 + cc * 8;
        kreg[i] = __builtin_nontemporal_load((const u32x4*)(src + (size_t)M * 512)); vreg[i] = __builtin_nontemporal_load((const u32x4*)(src + (size_t)2 * M * 512)); }
}
__device__ __forceinline__ void attn_load_q(const bf16_t* QKV, int b, int h, int g, int w, int fr, int fq, u32x4 (&qreg)[2]) {
    int p, r, n; attn_step_decode(g, p, r, n);
    const bf16_t* qs = QKV + ((size_t)(b * 8 + h) * SEQ + ((n * 128 + 16 * w + fr) << (2 * p)) + r) * 64 + fq * 8;
    qreg[0] = __builtin_nontemporal_load((const u32x4*)qs); qreg[1] = __builtin_nontemporal_load((const u32x4*)(qs + 32));
}
__device__ __forceinline__ void attn_store_kv(LAS unsigned char* lds, int slot, int tid, const u32x4 (&kreg)[2], const u32x4 (&vreg)[2]) {
#pragma unroll
    for (int i = 0; i < 2; ++i) { const int cid = tid + 512 * i, row = cid >> 3, cc = cid & 7;
        *(LAS u32x4*)(lds + slot * ASLOT + row * AKP + cc * 16) = kreg[i];
        *(LAS u32x4*)(lds + slot * ASLOT + ALDS_V + row * AVP + cc * 16) = vreg[i]; }
}
template <int DUMMY>
__device__ __forceinline__ void attn_step(const int g, LAS unsigned char* lds, const bf16_t* QKV, bf16_t* OY, float* LSE, const int b, const int h, const int w, const int tid, const int fr, const int fq,
                                          const float slope_base, u32x4 (&kreg)[2], u32x4 (&vreg)[2], u32x4 (&qreg)[2]) {
    constexpr int NSTEP = 48;
        asm volatile("s_waitcnt lgkmcnt(0)" ::: "memory"); __builtin_amdgcn_s_barrier(); asm volatile("" ::: "memory");
        if (g + 1 < NSTEP) attn_store_kv(lds, (g + 1) % 3, tid, kreg, vreg);
        int p, r, n; attn_step_decode(g, p, r, n);
        const size_t tok = (size_t)(b * SEQ + ((n * 128 + 16 * w + fr) << (2 * p)) + r);
        bf16_t* op = OY + tok * 768 + h * 64 + 8 * fq; float* lp = LSE + tok * 8 + h;
        u32x4 ro4[2]; float rl = 0.f;
        if (p > 0) { ro4[0] = __builtin_nontemporal_load((const u32x4*)op); ro4[1] = __builtin_nontemporal_load((const u32x4*)(op + 32)); rl = *lp; }
        if (g + 3 < NSTEP) attn_load_kv(QKV, b, h, g + 3, tid, kreg, vreg);
        const bf16x8 q0 = __builtin_bit_cast(bf16x8, qreg[0]), q1 = __builtin_bit_cast(bf16x8, qreg[1]);
        const int sc = g % 3, sp = (g + 2) % 3;
        const float slope2 = slope_base * (float)(1 << (2 * p));
        const int d0 = fr - 4 * fq; const float base = -slope2 * (float)(128 + d0);
        f32x4 sacc[9];
        __builtin_amdgcn_s_setprio(1);
#pragma unroll
        for (int jj = 0; jj < 9; ++jj) { const int jt = w + jj; const float bt = base + ((n > 0 || jt >= 8) ? 0.f : -1.0e30f);
            const LAS unsigned char* kp = lds + (jt >= 8 ? sc : sp) * ASLOT + (16 * (jt & 7) + fr) * AKP + fq * 16;
            const bf16x8 k0 = *(const LAS bf16x8*)kp, k1 = *(const LAS bf16x8*)(kp + 64);
            f32x4 z = (f32x4){bt + slope2 * (float)(16 * jj), bt + slope2 * (float)(16 * jj + 1), bt + slope2 * (float)(16 * jj + 2), bt + slope2 * (float)(16 * jj + 3)};
            z = __builtin_amdgcn_mfma_f32_16x16x32_bf16(k0, q0, z, 0, 0, 0);
            sacc[jj] = __builtin_amdgcn_mfma_f32_16x16x32_bf16(k1, q1, z, 0, 0, 0); }
        __builtin_amdgcn_s_setprio(0);
        if (g + 2 < NSTEP) attn_load_q(QKV, b, h, g + 2, w, fr, fq, qreg);
#pragma unroll
        for (int i = 0; i < 4; ++i) { sacc[0][i] = (i >= d0) ? sacc[0][i] : -1.0e30f; sacc[8][i] = (i <= d0) ? sacc[8][i] : -1.0e30f; }
        float mx = -3.0e38f;
#pragma unroll
        for (int jj = 0; jj < 9; ++jj)
#pragma unroll
            for (int i = 0; i < 4; ++i) mx = fmaxf(mx, sacc[jj][i]);
        mx = fmaxf(mx, __shfl_xor(mx, 16)); mx = fmaxf(mx, __shfl_xor(mx, 32));
        float lsum = 0.f; u32x2 pk[9];
#pragma unroll
        for (int jj = 0; jj < 9; ++jj) { float pp[4];
#pragma unroll
            for (int i = 0; i < 4; ++i) { pp[i] = __builtin_amdgcn_exp2f(sacc[jj][i] - mx); lsum += pp[i]; }
            pk[jj].x = cvt_pk_bf16(pp[0], pp[1]); pk[jj].y = cvt_pk_bf16(pp[2], pp[3]); }
        lsum += __shfl_xor(lsum, 16); lsum += __shfl_xor(lsum, 32);
        f32x4 oacc[4];
#pragma unroll
        for (int et = 0; et < 4; ++et) oacc[et] = (f32x4){0.f, 0.f, 0.f, 0.f};
        __builtin_amdgcn_s_setprio(1);
#pragma unroll
        for (int c = 0; c < 5; ++c) { const int ja = w + 2 * c, jb = (c < 4) ? ja + 1 : ja;
            {
                u32x4 pb; pb.x = pk[2 * c].x; pb.y = pk[2 * c].y; pb.z = (c < 4) ? pk[(c < 4) ? 2 * c + 1 : 0].x : 0u; pb.w = (c < 4) ? pk[(c < 4) ? 2 * c + 1 : 0].y : 0u;
                const bf16x8 pfrag = __builtin_bit_cast(bf16x8, pb);
                const LAS unsigned char* va_p = lds + (ja >= 8 ? sc : sp) * ASLOT + ALDS_V + (16 * (ja & 7) + 4 * fq + (fr >> 2)) * AVP + 16 * (fr & 3);
                const LAS unsigned char* vb_p = lds + (jb >= 8 ? sc : sp) * ASLOT + ALDS_V + (16 * (jb & 7) + 4 * fq + (fr >> 2)) * AVP + 16 * (fr & 3);
#pragma unroll
                for (int et = 0; et < 4; ++et) {
                    const u32x2 va = __builtin_bit_cast(u32x2, __builtin_amdgcn_ds_read_tr16_b64_v4i16((LAS v4i16_t*)(va_p + 64 * (et >> 1) + 8 * (et & 1))));
                    const u32x2 vb = __builtin_bit_cast(u32x2, __builtin_amdgcn_ds_read_tr16_b64_v4i16((LAS v4i16_t*)(vb_p + 64 * (et >> 1) + 8 * (et & 1))));
                    u32x4 vf; vf.x = va.x; vf.y = va.y; vf.z = vb.x; vf.w = vb.y;
                    oacc[et] = __builtin_amdgcn_mfma_f32_16x16x32_bf16(__builtin_bit_cast(bf16x8, vf), pfrag, oacc[et], 0, 0, 0); } } }
        __builtin_amdgcn_s_setprio(0);
        const float lse_n = mx + __builtin_amdgcn_logf(lsum); float ca = 0.f, cb = 1.f / lsum, lse_o = lse_n;
        if (p > 0) { const float mm = fmaxf(rl, lse_n), wr_ = __builtin_amdgcn_exp2f(rl - mm), wn_ = __builtin_amdgcn_exp2f(lse_n - mm), den = wr_ + wn_, rd = 1.f / den;
            ca = wr_ * rd; cb = wn_ * rd * cb; lse_o = mm + __builtin_amdgcn_logf(den); }
#pragma unroll
        for (int hf = 0; hf < 2; ++hf) { float o[8];
#pragma unroll
            for (int j = 0; j < 8; ++j) o[j] = oacc[2 * hf + (j >> 2)][j & 3] * cb;
            if (p > 0) { float rr[8]; unpack8(ro4[hf], rr);
#pragma unroll
                for (int j = 0; j < 8; ++j) o[j] += ca * rr[j]; }
            *(u32x4*)(op + 32 * hf) = pack8(o); }
        if (fq == 0 && p < 2) *lp = lse_o;
}

__device__ __forceinline__ void attn_phase(LAS unsigned char* lds, const bf16_t* QKV, bf16_t* OY, float* LSE, int bh, const int w, const int lane) {
    const int tid = w * 64 + lane, fr = lane & 15, fq = lane >> 4, b = bh >> 3, h = bh & 7;
    constexpr int NSTEP = 48;
    u32x4 kA[2], vA[2], kB[2], vB[2], qE[2], qO[2];
    for (int i = tid; i < ASLOT / 16; i += NTHR) *(LAS u32x4*)(lds + 2 * ASLOT + i * 16) = (u32x4){0u, 0u, 0u, 0u};
    attn_load_kv(QKV, b, h, 0, tid, kB, vB);
    attn_load_q(QKV, b, h, 0, w, fr, fq, qE);
    attn_store_kv(lds, 0, tid, kB, vB);
    attn_load_kv(QKV, b, h, 1, tid, kA, vA);
    attn_load_q(QKV, b, h, 1, w, fr, fq, qO);
    attn_load_kv(QKV, b, h, 2, tid, kB, vB);
    const float slope_base = __builtin_amdgcn_exp2f(-(float)(h + 1)) * LOG2E;
#pragma unroll 1
    for (int g = 0; g < NSTEP; g += 2) {
        attn_step<0>(g, lds, QKV, OY, LSE, b, h, w, tid, fr, fq, slope_base, kA, vA, qE);
        attn_step<1>(g + 1, lds, QKV, OY, LSE, b, h, w, tid, fr, fq, slope_base, kB, vB, qO);
    }
    __syncthreads();
}

__device__ __forceinline__ int lds_grab(LAS int* ctr, int lane) { int c = 0; if (lane == 0) c = __hip_atomic_fetch_add((int*)ctr, 1, __ATOMIC_RELAXED, __HIP_MEMORY_SCOPE_WORKGROUP); return __builtin_amdgcn_readfirstlane(c); }
__device__ __forceinline__ void modnorm_rows(const float* X, const float* gw, const float* MOD, int sh_off, int sc_off, bf16_t* XN, int row_base, int nrows, LAS int* ctr, int lane) {
    const int b = row_base >> 11, nchunk = nrows >> 2;
    f32x4 gm[4], shv[4];
    { const float* mp = MOD + b * 6144 + 4 * lane;
#pragma unroll
      for (int j = 0; j < 4; ++j) { const f32x4 g4 = *(const f32x4*)(gw + 4 * lane + 256 * j), sc = *(const f32x4*)(mp + sc_off + 256 * j); shv[j] = *(const f32x4*)(mp + sh_off + 256 * j);
          gm[j] = (f32x4){g4[0] * (1.f + sc[0]), g4[1] * (1.f + sc[1]), g4[2] * (1.f + sc[2]), g4[3] * (1.f + sc[3])}; } }
    int ch = lds_grab(ctr, lane);
    if (ch >= nchunk) return;
    f32x4 v[4][4], nv[4][4];
#pragma unroll
    for (int q = 0; q < 4; ++q) { const f32x4* xr = (const f32x4*)(X + (size_t)(row_base + 4 * ch + q) * DM) + lane;
#pragma unroll
        for (int j = 0; j < 4; ++j) v[q][j] = __builtin_nontemporal_load(xr + 64 * j); }
    for (;;) {
        const int nch = lds_grab(ctr, lane); const bool more = nch < nchunk; const int pch = more ? nch : ch;
#pragma unroll
        for (int q = 0; q < 4; ++q) { const f32x4* xr = (const f32x4*)(X + (size_t)(row_base + 4 * pch + q) * DM) + lane;
#pragma unroll
            for (int j = 0; j < 4; ++j) nv[q][j] = __builtin_nontemporal_load(xr + 64 * j); }
#pragma unroll
        for (int q = 0; q < 4; ++q) { const int row = row_base + 4 * ch + q; float s = 0.f;
#pragma unroll
            for (int j = 0; j < 4; ++j) s += (v[q][j][0] * v[q][j][0] + v[q][j][1] * v[q][j][1]) + (v[q][j][2] * v[q][j][2] + v[q][j][3] * v[q][j][3]);
            const float rstd = 1.f / sqrtf(wave_sum(s) * (1.f / DM) + EPS);
#pragma unroll
            for (int j = 0; j < 4; ++j) { float o[4];
#pragma unroll
                for (int e = 0; e < 4; ++e) o[e] = (v[q][j][e] * rstd) * gm[j][e] + shv[j][e];
                u32x2 pkd; pkd.x = cvt_pk_bf16(o[0], o[1]); pkd.y = cvt_pk_bf16(o[2], o[3]);
                *(u32x2*)(XN + (size_t)row * DM + 4 * lane + 256 * j) = pkd; } }
        if (!more) break;
        ch = nch;
#pragma unroll
        for (int q = 0; q < 4; ++q)
#pragma unroll
            for (int j = 0; j < 4; ++j) v[q][j] = nv[q][j];
    }
}

constexpr int TI_IN = (DM / 64) * (INW / 32), TI_PA = (AW / 64) * (DM / 32), TI_PS = (SW / 64) * (DM / 32), TI_GLU = (SW / 64) * (SW / 32), TI_OUT = (DM / 64) * (DM / 32),
              TI_UP = (DM / 64) * (2 * FF / 32), TI_DN = (FF / 64) * (DM / 32), NIT = TI_IN + TI_PA + TI_PS + TI_GLU + TI_OUT + TI_UP + TI_DN, NIT0 = 2048;
typedef const __attribute__((address_space(4))) Args* KArgs;
__device__ __forceinline__ void transpose_any(KArgs ka, int it, LAS float* scr, int lane) {
    unsigned char* wsb = ka->ws; int r = it;
    if (r < TI_IN) { transpose_item(ka->in[5], DM, INW, (bf16_t*)(wsb + WS_WIN), scr, r, lane); return; } r -= TI_IN;
    if (r < TI_PA) { transpose_item(ka->in[17], AW, DM, (bf16_t*)(wsb + WS_WPA), scr, r, lane, false, AW + SW, 0); return; } r -= TI_PA;
    if (r < TI_PS) { transpose_item(ka->in[18], SW, DM, (bf16_t*)(wsb + WS_WPA), scr, r, lane, false, AW + SW, AW); return; } r -= TI_PS;
    if (r < TI_GLU) { transpose_item(ka->in[15], SW, SW, (bf16_t*)(wsb + WS_WGLU), scr, r, lane); return; } r -= TI_GLU;
    if (r < TI_OUT) { transpose_item(ka->in[19], DM, DM, (bf16_t*)(wsb + WS_WOUT), scr, r, lane); return; } r -= TI_OUT;
    if (r < TI_UP) { transpose_item(ka->in[21], DM, 2 * FF, (bf16_t*)(wsb + WS_WUP), scr, r, lane, true); return; } r -= TI_UP;
    transpose_item(ka->in[24], FF, DM, (bf16_t*)(wsb + WS_WDN), scr, r, lane);
}

#define XB_TMO      128
#define XB_XCNT(j)  (256  + 64 * (j))
#define XB_XSUB(j)  (1280 + 64 * (j))
#define XB_XGEN(j)  (2304 + 64 * (j))
#define XB_TOP      3328
#define XB_TOPGEN   3392
#define XCD_BAR_WORDS 3456
#define XB_SPIN_CAP (1u << 22)
__device__ __forceinline__ unsigned xb_ld(unsigned* p)              { return __hip_atomic_load(p, __ATOMIC_RELAXED, __HIP_MEMORY_SCOPE_AGENT); }
__device__ __forceinline__ unsigned xb_add(unsigned* p, unsigned v) { return __hip_atomic_fetch_add(p, v, __ATOMIC_RELAXED, __HIP_MEMORY_SCOPE_AGENT); }
__device__ __forceinline__ unsigned xb_xcc_id() { return (unsigned)__builtin_amdgcn_s_getreg((3 << 11) | 20) & 0xFu; }
#define XB_SPIN(cond, bar) do { unsigned _sp = 0; while (cond) { __builtin_amdgcn_s_sleep(1); \
    if ((++_sp & 255u) == 0u) { if (xb_ld(&(bar)[XB_TMO])) break; if (_sp > XB_SPIN_CAP) { atomicAdd(&(bar)[XB_TMO], 1u); break; } } } } while (0)
__device__ __forceinline__ void xcd_barrier_complete(unsigned* bar, unsigned x, unsigned G, unsigned& nloc, unsigned& nx) {
    unsigned sum, cnt, mine, sp = 0u;
    for (;;) {
        sum = 0u; cnt = 0u; mine = 0u;
#pragma unroll
        for (unsigned j = 0; j < 16; ++j) { const unsigned c = xb_ld(&bar[XB_XCNT(j)]); sum += c; cnt += (c > 0u) ? 1u : 0u; mine = (j == x) ? c : mine; }
        if (sum == G) break;
        __builtin_amdgcn_s_sleep(1);
        if ((++sp & 255u) == 0u) { if (xb_ld(&bar[XB_TMO])) break; if (sp > XB_SPIN_CAP) { atomicAdd(&bar[XB_TMO], 1u); break; } }
    }
    nloc = mine > 0u ? mine : 1u; nx = cnt > 0u ? cnt : 1u;
}
__device__ __forceinline__ void grid_barrier(unsigned* bar, unsigned x, volatile LAS unsigned* st, unsigned G, int wave) {
    asm volatile("s_waitcnt vmcnt(0)" ::: "memory");
    __syncthreads();
    if (wave == 0) {
        int z_; asm volatile("s_mov_b32 %0, 0" : "=s"(z_));
        if ((int)__builtin_amdgcn_mbcnt_hi(~0u, __builtin_amdgcn_mbcnt_lo(~0u, (unsigned)z_)) == 0) {
            __builtin_amdgcn_s_waitcnt(0);
            unsigned nloc = st[0], nx = st[1];
            if (nloc == 0u) { xcd_barrier_complete(bar, x, G, nloc, nx); st[0] = nloc; st[1] = nx; }
            const unsigned old = xb_add(&bar[XB_XSUB(x)], 1u);
            const unsigned gen = old / nloc;
            if (old + 1u == (gen + 1u) * nloc) {
                __builtin_amdgcn_fence(__ATOMIC_RELEASE, "agent");
                asm volatile("s_waitcnt vmcnt(0)" ::: "memory");
                const unsigned og = xb_add(&bar[XB_TOP], 1u);
                const unsigned tg = og / nx;
                if (og + 1u == (tg + 1u) * nx) xb_add(&bar[XB_TOPGEN], 1u);
                else XB_SPIN(xb_ld(&bar[XB_TOPGEN]) == tg, bar);
                __builtin_amdgcn_fence(__ATOMIC_ACQUIRE, "agent");
                xb_add(&bar[XB_XGEN(x)], 1u);
                asm volatile("s_waitcnt vmcnt(0)" ::: "memory");
            } else {
                XB_SPIN(xb_ld(&bar[XB_XGEN(x)]) == gen, bar);
                __builtin_amdgcn_fence(__ATOMIC_ACQUIRE, "agent");
                asm volatile("s_waitcnt vmcnt(0)" ::: "memory");
            }
        }
    }
    __syncthreads();
}

__global__ void __launch_bounds__(NTHR, 2) fwd(Args a) {
    __builtin_assume(__builtin_amdgcn_workitem_id_y() == 0); __builtin_assume(__builtin_amdgcn_workitem_id_z() == 0);
    extern __shared__ __attribute__((aligned(16))) unsigned char lds_raw[];
    LAS unsigned char* lds = (LAS unsigned char*)lds_raw;
    const int wave = __builtin_amdgcn_readfirstlane((int)threadIdx.x >> 6);
    const int G = gridDim.x, bx = blockIdx.x;
    const int vcu = (G % 8 == 0) ? (bx % 8) * (G / 8) + bx / 8 : bx;
    const int gwave = vcu * NWAVES + wave, ngw = G * NWAVES;
    const int ngt = G * NTHR;
    const KArgs ka = (KArgs)__builtin_amdgcn_kernarg_segment_ptr();
#define ws (ka->ws)
#define x (ka->in[0])
#define cvec (ka->in[1])
#define w_ada (ka->in[2])
#define b_ada (ka->in[3])
#define g_mix (ka->in[4])
#define w_in (ka->in[5])
#define b_gate (ka->in[6])
#define a_re (ka->in[7])
#define a_im (ka->in[8])
#define log_dt (ka->in[9])
#define b_re (ka->in[10])
#define b_im (ka->in[11])
#define c_re (ka->in[12])
#define c_im (ka->in[13])
#define d_skip (ka->in[14])
#define w_glu (ka->in[15])
#define b_glu (ka->in[16])
#define w_pa (ka->in[17])
#define w_ps (ka->in[18])
#define w_out (ka->in[19])
#define g_ffn (ka->in[20])
#define w_up (ka->in[21])
#define w_conv (ka->in[22])
#define b_conv (ka->in[23])
#define w_down (ka->in[24])
#define g_final (ka->in[25])
#define out (ka->out)
#define MOD ((float*)(ws + WS_MOD))
#define KS ((float*)(ws + WS_KS))
#define ATC ((float*)(ws + WS_ATC))
#define MODE ((double*)(ws + WS_MODE))
#define PW ((double*)(ws + WS_PW))
#define WIN ((bf16_t*)(ws + WS_WIN))
#define WPA ((bf16_t*)(ws + WS_WPA))
#define WPS ((bf16_t*)(ws + WS_WPS))
#define WGLU ((bf16_t*)(ws + WS_WGLU))
#define WOUT ((bf16_t*)(ws + WS_WOUT))
#define WUP ((bf16_t*)(ws + WS_WUP))
#define WDN ((bf16_t*)(ws + WS_WDN))
#define WST ((bf16_t*)(ws + WS_WST))
#define KW ((bf16_t*)(ws + WS_KW))
#define SLOC4 ((float*)(ws + WS_SLOC4))
#define LSE ((float*)(ws + WS_LSE))
#define XN ((bf16_t*)(ws + WS_XN))
#define QKV ((bf16_t*)(ws + WS_QKV))
#define OATT ((bf16_t*)(ws + WS_OATT))
#define Y2 ((bf16_t*)(ws + WS_Y2))
#define YG ((bf16_t*)(ws + WS_YG))
#define GATES ((bf16_t*)(ws + WS_GATES))
#define UX ((bf16_t*)(ws + WS_UX))
#define OP ((bf16_t*)(ws + WS_OP))
#define UP ((bf16_t*)(ws + WS_UP))
#define HB ((bf16_t*)(ws + WS_HB))
#define HBF ((bf16_t*)(ws + WS_HBF))
#define SSQ ((float*)(ws + WS_SSQ))
#define SHW ((float*)(ws + WS_SHW))
    const int lo = ka->ph_lo, hi = ka->ph_hi;
#ifndef PHMASK
#define PHMASK 0xffff
#endif
#define IN(k) (((PHMASK >> (k)) & 1) && lo <= (k) && (k) < hi)
#define IDS() int z_; asm volatile("s_mov_b32 %0, 0" : "=s"(z_)); const int lane = (int)__builtin_amdgcn_mbcnt_hi(~0u, __builtin_amdgcn_mbcnt_lo(~0u, (unsigned)z_)); const int tid = wave * 64 + lane; const int gthr = vcu * NTHR + tid; (void)gthr; (void)tid
    if (lo < 0) cg::this_grid().sync();
    unsigned* const xbar = (unsigned*)(ws + 16384); const unsigned xcc = xb_xcc_id();
    volatile LAS unsigned* const xst = (volatile LAS unsigned*)(lds + 147456 - 64);
    if (__builtin_amdgcn_workitem_id_x() == 0) { xst[0] = 0u; xst[1] = 0u; (void)xb_add(&xbar[XB_XCNT(xcc)], 1u); }
    __syncthreads();
#define SEAM(k) do { if (IN(k) && IN((k) + 1)) grid_barrier(xbar, xcc, xst, (unsigned)G, wave); } while (0)

    if (IN(0)) { IDS();
        if (bx < 192) gemv32<true, false>(lds, cvec, DM, w_ada, 6 * DM, bx * 32, b_ada, MOD, 6 * DM, tid, wave, lane);
        else {
            if (tid < 16) { const int it = (bx - 192) * 16 + tid, g = it >> 6, n = it & 63;
                const SsmMode mo = ssm_mode(a_re, a_im, log_dt, g, n);
                double* md = MODE + (size_t)it * 4; md[0] = mo.ab.re; md[1] = mo.ab.im; md[2] = mo.f.re; md[3] = mo.f.im;
                double* pw = PW + (size_t)it * 130; cplx p{1.0, 0.0};
                for (int t = 0; t <= TCH; ++t) { pw[2 * t] = p.re; pw[2 * t + 1] = p.im; p = cmul(p, mo.ab); }
                ATC[it * 2] = (float)pw[2 * TCH]; ATC[it * 2 + 1] = (float)pw[2 * TCH + 1]; }
            LAS float* scr = (LAS float*)(lds + wave * 16384);
            for (int it = (bx - 192) * NWAVES + wave; it < NIT0; it += 64 * NWAVES) transpose_any(ka, it, scr, lane);
        }
    }
    SEAM(0);
    if (IN(1)) { IDS();
        { LAS float* scr = (LAS float*)(lds + wave * 16384);
          for (int it = NIT0 + gwave; it < NIT; it += ngw) transpose_any(ka, it, scr, lane); }
        LAS int* ctr = (LAS int*)(lds + 131072 + 8192);
        if (tid == 0) *ctr = 0;
        __syncthreads();
        if (wave == 7) { const int it = vcu * 64 + lane, g = it >> 10, tau = (it >> 4) & 63, c = it & 15;
            double kacc[16];
#pragma unroll
            for (int j = 0; j < 16; ++j) kacc[j] = 0.0;
            for (int n = 0; n < SN; ++n) { const double* md = MODE + (size_t)(g * SN + n) * 4; const double* pw = PW + (size_t)(g * SN + n) * 130 + 2 * tau;
                const cplx cc = cplx{(double)c_re[(g * SC + c) * SN + n], (double)c_im[(g * SC + c) * SN + n]}; const cplx ca = cmul(cmul(cc, cplx{pw[0], pw[1]}), cplx{md[2], md[3]});
#pragma unroll
                for (int j = 0; j < 16; ++j) { const double br = (double)b_re[(g * SN + n) * SC + j], bi = (double)b_im[(g * SN + n) * SC + j]; kacc[j] += ca.re * br - ca.im * bi; } }
#pragma unroll
            for (int j = 0; j < 16; ++j) KS[(size_t)it * 16 + j] = (float)kacc[j]; }
        if (wave >= 3 && wave < 7) { const int it = ((wave - 3) * G + vcu) * 64 + lane, g = it >> 12, n = (it >> 6) & 63, s = it & 63;
            const double* md = MODE + (size_t)(g * SN + n) * 4; const double* pwt = PW + (size_t)(g * SN + n) * 130; const cplx fm{md[2], md[3]};
            { const cplx pf = cmul(cplx{pwt[2 * (TCH - 1 - s)], pwt[2 * (TCH - 1 - s) + 1]}, fm); float wre[16], wim[16];
#pragma unroll
              for (int j = 0; j < 16; ++j) { const double br = (double)b_re[(g * SN + n) * SC + j], bi = (double)b_im[(g * SN + n) * SC + j]; wre[j] = (float)(pf.re * br - pf.im * bi); wim[j] = (float)(pf.re * bi + pf.im * br); }
              bf16_t* d0 = WST + (size_t)(g * 256 + n) * 1024 + s * 16; bf16_t* d1 = d0 + (size_t)64 * 1024;
              *(u32x4*)d0 = pack8(wre); *(u32x4*)(d0 + 8) = pack8(wre + 8); *(u32x4*)d1 = pack8(wim); *(u32x4*)(d1 + 8) = pack8(wim + 8);
              bf16_t* z0 = d0 + (size_t)128 * 1024; bf16_t* z1 = d1 + (size_t)128 * 1024; const u32x4 zz = (u32x4){0u, 0u, 0u, 0u};
              *(u32x4*)z0 = zz; *(u32x4*)(z0 + 8) = zz; *(u32x4*)z1 = zz; *(u32x4*)(z1 + 8) = zz; }
            { const int i = s; const cplx pw{pwt[2 * (i + 1)], pwt[2 * (i + 1) + 1]};
              for (int c = 0; c < SC; ++c) { const cplx cc = cplx{(double)c_re[(g * SC + c) * SN + n], (double)c_im[(g * SC + c) * SN + n]}; const cplx ca = cmul(cc, pw);
                  bf16_t* d = KW + (size_t)(g * 1024 + i * 16 + c) * KX + 1024 + n;
                  d[0] = (bf16_t)(cvt_pk_bf16((float)ca.re, 0.f) & 0xffffu); d[64] = (bf16_t)(cvt_pk_bf16((float)(-ca.im), 0.f) & 0xffffu); } }
        }
        modnorm_rows(x, g_mix, MOD, 0, 1024, XN, vcu * (M / G), M / G, ctr, lane);
    }
    SEAM(1);
    if (IN(2)) { IDS();
        pg8::Gemm g{XN, WIN, DM, DM, DM}; pg8::StaticOrder S; S.init(M, INW, G, bx);
        pg8::EpiInProj E{QKV, UX, GATES, b_gate};
        pg8::gemm_phase(lds, g, S, E, wave, lane);
    }
    SEAM(2);
    if (IN(3)) { IDS();
        { const int kq = bx & 3; pg8::Gemm g{UX + kq * 256, WST + kq * 256, KX, 1024, 256}; pg8::SchedS1 S{bx}; pg8::EpiS1 E{SLOC4 + (size_t)kq * (SG * 1024 * 128)}; pg8::gemm_phase(lds, g, S, E, wave, lane); }
        attn_phase(lds, QKV, OATT, LSE, bx, wave, lane);
        for (int it = gthr; it < SG * TCH * SC * TCH; it += ngt) { const int g = it >> 16, i = (it >> 10) & 63, c = (it >> 6) & 15, s = it & 63;
            u32x4 o0 = (u32x4){0u, 0u, 0u, 0u}, o1 = o0;
            if (s <= i) { const float* kp = KS + ((size_t)((g * 64 + (i - s)) * 16 + c)) * 16; float kv[16];
#pragma unroll
                for (int j = 0; j < 16; ++j) kv[j] = kp[j];
                o0 = pack8(kv); o1 = pack8(kv + 8); }
            bf16_t* d = KW + (size_t)(g * 1024 + i * 16 + c) * KX + s * 16; *(u32x4*)d = o0; *(u32x4*)(d + 8) = o1; }
    }
    SEAM(3);
    if (IN(5)) { IDS();
        {
            const int g = bx >> 4, pmm = (bx >> 2) & 3, bl = tid >> 6, n = tid & 63; constexpr size_t PS = (size_t)SG * 1024 * 128;
            const float ar = ATC[(g * SN + n) * 2], ai = ATC[(g * SN + n) * 2 + 1]; float xr = 0.f, xi = 0.f;
            for (int c8 = 0; c8 < NCH; c8 += 16) { float sr[16], si[16];
#pragma unroll
                for (int q = 0; q < 16; ++q) { const size_t rowi = (size_t)(g * 1024 + pmm * 256 + bl * NCH + c8 + q); const float* sp0 = SLOC4 + rowi * 128 + n;
                    sr[q] = (sp0[0] + sp0[PS]) + (sp0[2 * PS] + sp0[3 * PS]); si[q] = (sp0[64] + sp0[PS + 64]) + (sp0[2 * PS + 64] + sp0[3 * PS + 64]); }
#pragma unroll
                for (int q = 0; q < 16; ++q) { const size_t rowi = (size_t)(g * 1024 + pmm * 256 + bl * NCH + c8 + q);
                    bf16_t* d = UX + rowi * KX + 1024 + n; d[0] = (bf16_t)(cvt_pk_bf16(xr, 0.f) & 0xffffu); d[64] = (bf16_t)(cvt_pk_bf16(xi, 0.f) & 0xffffu);
                    const float nr = ar * xr - ai * xi + sr[q], ni = ar * xi + ai * xr + si[q]; xr = nr; xi = ni; } }
            asm volatile("s_waitcnt vmcnt(0)" ::: "memory"); __syncthreads();
        }
        pg8::Gemm g{UX, KW, KX, KX, KX}; pg8::SchedS3 S{G, bx}; pg8::EpiS3 E{UX, d_skip, Y2}; pg8::gemm_phase(lds, g, S, E, wave, lane); }
    SEAM(5);
    if (IN(6)) { IDS(); pg8::Gemm g{Y2, WGLU, SW, SW, SW}; pg8::StaticOrder S; S.init(M, SW, G, bx); pg8::EpiGlu E{Y2, b_glu, OATT}; pg8::gemm_phase(lds, g, S, E, wave, lane);
        if (bx < 128) gemv32<false, true>(lds, MOD + 3072, 6 * DM, w_up, 2 * FF, bx * 32, nullptr, SHW, 2 * FF, tid, wave, lane); }
    SEAM(6);
    if (IN(7)) { IDS();
        pg8::Gemm g{OATT, WPA, AW + SW, AW + SW, AW + SW}; pg8::StaticOrder S; S.init(M, DM, G, bx); pg8::EpiMerge1 E{GATES, XN};
        pg8::gemm_phase<pg8::EpiMerge1, pg8::StaticOrder, 8>(lds, g, S, E, wave, lane);
    }
    SEAM(7);
    if (IN(8)) { IDS(); pg8::Gemm g{XN, WOUT, DM, DM, DM}; pg8::StaticOrder S; S.init(M, DM, G, bx); pg8::EpiResNorm E{x, MOD, g_ffn, HBF, HB, SSQ}; pg8::gemm_phase(lds, g, S, E, wave, lane); }
    SEAM(8);
    if (IN(10)) { IDS(); pg8::Gemm g{HB, WUP, DM, DM, DM}; pg8::SchedChain S{bx}; pg8::EpiUpConv E{UP, w_conv, b_conv, (LAS float*)(lds + 131072), SSQ, SHW}; pg8::gemm_phase(lds, g, S, E, wave, lane); }
    SEAM(10);
    if (IN(12)) { IDS(); pg8::Gemm g{UP, WDN, FF, FF, FF}; pg8::StaticOrder S; S.init(M, DM, G, bx); pg8::EpiResFinal E{HBF, MOD + 5120, g_final, out, (float*)(ws + WS_XCH), (unsigned*)(ws + WS_CNT), (LAS float*)(lds + 131072 + 8192)}; pg8::gemm_phase(lds, g, S, E, wave, lane); }
#undef IN
#undef SEAM
}
#undef ws
#undef HBF
#undef SLOC4
#undef HB
#undef SSQ
#undef SHW
#undef MODE
#undef PW
#undef x
#undef cvec
#undef w_ada
#undef b_ada
#undef g_mix
#undef w_in
#undef b_gate
#undef a_re
#undef a_im
#undef log_dt
#undef b_re
#undef b_im
#undef c_re
#undef c_im
#undef d_skip
#undef w_glu
#undef b_glu
#undef w_pa
#undef w_ps
#undef w_out
#undef g_ffn
#undef w_up
#undef w_conv
#undef b_conv
#undef w_down
#undef g_final
#undef out
#undef MOD
#undef KS
#undef ATC
#undef WIN
#undef WPA
#undef WPS
#undef WGLU
#undef WOUT
#undef WUP
#undef WDN
#undef WST
#undef KW
#undef SLOC
#undef LSE
#undef XN
#undef QKV
#undef OATT
#undef Y2
#undef YG
#undef GATES
#undef UX
#undef OP
#undef UP

constexpr int N_PHASES = 14;
constexpr int LDS_BYTES = 147456;
extern "C" void kernel_launch(void* const* d_in, const int* in_sizes, int n_in, void* d_out, int out_size, void* d_ws, size_t ws_size, hipStream_t stream) {
    static int grid = 0;
    if (grid == 0) {
        if (n_in != 26 || in_sizes[0] != M * DM || out_size != M * DM || ws_size < WS_END) { fprintf(stderr, "kernel_launch: unexpected shapes (n_in %d in0 %d out %d ws %zu)\n", n_in, n_in > 0 ? in_sizes[0] : -1, out_size, ws_size); grid = -1; return; }
        int dev = 0, cus = 0, per_cu = 0;
        (void)hipGetDevice(&dev); (void)hipDeviceGetAttribute(&cus, hipDeviceAttributeMultiprocessorCount, dev);
        if (hipFuncSetAttribute((const void*)fwd, hipFuncAttributeMaxDynamicSharedMemorySize, LDS_BYTES) != hipSuccess) { fprintf(stderr, "kernel_launch: hipFuncSetAttribute failed\n"); grid = -1; return; }
        if (hipOccupancyMaxActiveBlocksPerMultiprocessor(&per_cu, (const void*)fwd, NTHR, LDS_BYTES) != hipSuccess || per_cu < 1) { fprintf(stderr, "kernel_launch: occupancy query says %d\n", per_cu); per_cu = 1; }
        (void)hipGetLastError();
        grid = cus * 1;
        if (grid != 256) { fprintf(stderr, "kernel_launch: built for a 256-CU device (got %d)\n", cus); grid = -1; return; }
        fprintf(stderr, "kernel_launch: grid %d (cus %d, per_cu %d)\n", grid, cus, per_cu);
    }
    if (grid < 0) return;
    (void)hipMemsetAsync(d_ws, 0, 32768, stream);
    Args a{};
    for (int i = 0; i < 26; ++i) a.in[i] = (const float*)d_in[i];
    a.out = (float*)d_out; a.ws = (unsigned char*)d_ws;
#if MK_SINGLE
    a.ph_lo = 0; a.ph_hi = N_PHASES;
    { void* args[] = {&a}; hipError_t e = hipLaunchCooperativeKernel((const void*)fwd, dim3(grid), dim3(NTHR), args, LDS_BYTES, stream);
      if (e != hipSuccess) fprintf(stderr, "cooperative launch failed: %s\n", hipGetErrorString(e)); }
#else
    for (int ph = 0; ph < N_PHASES; ++ph) for (int rep = 0; rep < (((PROBE_MASK >> ph) & 1) ? 1 + PROBE_REPS : 1); ++rep) { a.ph_lo = ph; a.ph_hi = ph + 1; void* args[] = {&a};
        hipError_t e = hipLaunchCooperativeKernel((const void*)fwd, dim3(grid), dim3(NTHR), args, LDS_BYTES, stream);
        if (e != hipSuccess) { fprintf(stderr, "cooperative launch %d failed: %s\n", ph, hipGetErrorString(e)); break; } }
#endif
}
```
